# Optimizing an MI355X kernel written in HIP

```python
import jax, jax.numpy as jnp
from jax import lax
import numpy as np

D_MODEL = 2048
BATCH = 2
SEQ = 4096
DEPTH = 4

GRID_W = 64
CTX_LEN = 256
N_MIXERS = 2
N_GLA_LAYERS = (DEPTH + 1) // 2
N_FNET_LAYERS = DEPTH // 2
GLA_HEADS = 4
GLA_KEY_DIM = D_MODEL // 2
GLA_VALUE_DIM = D_MODEL
GLA_HEAD_K = GLA_KEY_DIM // GLA_HEADS
GLA_HEAD_V = GLA_VALUE_DIM // GLA_HEADS
GLA_GATE_RANK = 16
GLA_GATE_TAU = 16.0
GLA_CHUNK = 64
GLA_IN_DIM = 2 * GLA_KEY_DIM + 2 * GLA_VALUE_DIM + 2 * GLA_GATE_RANK
GLA_SPLITS = (GLA_KEY_DIM, 2 * GLA_KEY_DIM, 2 * GLA_KEY_DIM + GLA_VALUE_DIM,
              2 * GLA_KEY_DIM + 2 * GLA_VALUE_DIM, 2 * GLA_KEY_DIM + 2 * GLA_VALUE_DIM + GLA_GATE_RANK)
FNET_GROUPS = 4
FNET_GROUP_DIM = D_MODEL // FNET_GROUPS
D_FF = -(-8 * D_MODEL // (3 * 256)) * 256
N_ADA = 6
N_NORMS = 4
EPS = 1e-6

kernel_name = "hybrid_gla_fnet_prefix_dit"


def rms_norm(x, gain):
    x32 = x.astype(jnp.float32)
    y = x32 * lax.rsqrt(jnp.mean(x32 * x32, axis=-1, keepdims=True) + EPS)
    return (y * gain.astype(jnp.float32)).astype(x.dtype)


def modulate(x, gain, shift, scale):
    return rms_norm(x, gain) * (1 + scale) + shift


def to_col_major(x, rows):
    b, s, d = x.shape
    return x.reshape(b, rows, GRID_W, d).transpose(0, 2, 1, 3).reshape(b, s, d)


def to_row_major(x, rows):
    b, s, d = x.shape
    return x.reshape(b, GRID_W, rows, d).transpose(0, 2, 1, 3).reshape(b, s, d)


def gla_chunk_scan(q, k, v, g, s0):
    b, h, l, _ = q.shape
    dv = v.shape[-1]
    n = l // GLA_CHUNK
    q, k, v, g = (t.astype(jnp.float32).reshape(b, h, n, GLA_CHUNK, t.shape[-1]) for t in (q, k, v, g))
    cum = jnp.cumsum(g, axis=3)
    last = cum[:, :, :, -1:, :]
    q_dec = q * jnp.exp(cum)
    k_inv = k * jnp.exp(-cum)
    k_end = k * jnp.exp(last - cum)
    mask = jnp.tril(jnp.ones((GLA_CHUNK, GLA_CHUNK), dtype=bool))
    scores = jnp.where(mask, jnp.einsum('bhnid,bhnjd->bhnij', q_dec, k_inv), 0.0)
    o_intra = jnp.einsum('bhnij,bhnje->bhnie', scores, v)
    decay = jnp.exp(last[:, :, :, 0, :])

    def step(state, xs):
        qc, kc, vc, dc = xs
        o = jnp.einsum('bhcd,bhde->bhce', qc, state)
        state = dc[..., None] * state + jnp.einsum('bhcd,bhce->bhde', kc, vc)
        return state, o

    xs = tuple(jnp.moveaxis(t, 2, 0) for t in (q_dec, k_end, v, decay))
    s_final, o_inter = lax.scan(step, s0.astype(jnp.float32), xs)
    o = o_intra + jnp.moveaxis(o_inter, 0, 2)
    return o.reshape(b, h, l, dv), s_final


def gla_project(h, w_in, wg2_f, bg_f, wg2_b, bg_b):
    b, l, _ = h.shape
    q, k, v, r, lf, lb = jnp.split(h @ w_in, GLA_SPLITS, axis=-1)

    def heads(t, d):
        return t.reshape(b, l, GLA_HEADS, d).transpose(0, 2, 1, 3)

    def log_gate(low, w2, b2):
        return heads(jax.nn.log_sigmoid((low @ w2 + b2).astype(jnp.float32)) / GLA_GATE_TAU, GLA_HEAD_K)

    q = heads(q, GLA_HEAD_K) * GLA_HEAD_K ** -0.5
    k = heads(k, GLA_HEAD_K)
    v = heads(v, GLA_HEAD_V)
    return q, k, v, r, log_gate(lf, wg2_f, bg_f), log_gate(lb, wg2_b, bg_b)


def gla_output(o, r, head_gain, w_out):
    b, h, l, dv = o.shape
    o = o * lax.rsqrt(jnp.mean(o * o, axis=-1, keepdims=True) + EPS) * head_gain.astype(jnp.float32)
    o = o.transpose(0, 2, 1, 3).reshape(b, l, h * dv).astype(r.dtype)
    return (o * jax.nn.silu(r)) @ w_out


def gla_mix(h_lat, h_ctx, w_in, wg2_f, bg_f, wg2_b, bg_b, head_gain, w_out, need_ctx):
    qc, kc, vc, rc, gcf, gcb = gla_project(h_ctx, w_in, wg2_f, bg_f, wg2_b, bg_b)
    ql, kl, vl, rl, glf, glb = gla_project(h_lat, w_in, wg2_f, bg_f, wg2_b, bg_b)
    zero = jnp.zeros((h_lat.shape[0], GLA_HEADS, GLA_HEAD_K, GLA_HEAD_V), jnp.float32)

    def flip(t):
        return t[:, :, ::-1]

    oc_f, sc_f = gla_chunk_scan(qc, kc, vc, gcf, zero)
    oc_b, sc_b = gla_chunk_scan(flip(qc), flip(kc), flip(vc), flip(gcb), zero)
    ol_f, _ = gla_chunk_scan(ql, kl, vl, glf, sc_f)
    ol_b, _ = gla_chunk_scan(flip(ql), flip(kl), flip(vl), flip(glb), sc_b)
    y_lat = gla_output(ol_f + flip(ol_b), rl, head_gain, w_out)
    y_ctx = gla_output(oc_f + flip(oc_b), rc, head_gain, w_out) if need_ctx else None
    return y_lat, y_ctx


def fnet_mix(h, w_out):
    b, l, d = h.shape
    hg = h.astype(jnp.float32).reshape(b, l, FNET_GROUPS, FNET_GROUP_DIM)
    f = jnp.fft.fft2(hg, axes=(1, 3), norm="ortho").real
    return f.reshape(b, l, d).astype(h.dtype) @ w_out


def swiglu(h, w_gu, w_down):
    gate, up = jnp.split(h @ w_gu, 2, axis=-1)
    return (jax.nn.silu(gate) * up) @ w_down


def setup_inputs(seed: int = 0) -> dict:
    key = jax.random.key(seed)
    ks = jax.random.split(key, 20)
    d = D_MODEL

    def nrm(k, shape, fan_in):
        return jax.random.normal(k, shape, jnp.float32) * fan_in ** -0.5

    def small(k, shape, s):
        return s * jax.random.normal(k, shape, jnp.float32)

    return {
        "x": jax.random.normal(ks[0], (BATCH, SEQ, d), jnp.float32),
        "c": jax.random.normal(ks[1], (BATCH, d), jnp.float32),
        "ctx": jax.random.normal(ks[2], (BATCH, CTX_LEN, d), jnp.float32),
        "c_ctx": jax.random.normal(ks[3], (d,), jnp.float32),
        "ada_w": nrm(ks[4], (DEPTH, d, N_ADA * d), d),
        "ada_b": small(ks[5], (DEPTH, N_ADA * d), 0.02),
        "norm_gains": 1.0 + small(ks[6], (DEPTH, N_NORMS, d), 0.05),
        "gla_w_in": nrm(ks[7], (N_GLA_LAYERS, d, GLA_IN_DIM), d),
        "gla_wg2_f": nrm(ks[8], (N_GLA_LAYERS, GLA_GATE_RANK, GLA_KEY_DIM), GLA_GATE_RANK),
        "gla_bg_f": small(ks[9], (N_GLA_LAYERS, GLA_KEY_DIM), 0.1),
        "gla_wg2_b": nrm(ks[10], (N_GLA_LAYERS, GLA_GATE_RANK, GLA_KEY_DIM), GLA_GATE_RANK),
        "gla_bg_b": small(ks[11], (N_GLA_LAYERS, GLA_KEY_DIM), 0.1),
        "gla_head_gain": 1.0 + small(ks[12], (N_GLA_LAYERS, GLA_HEAD_V), 0.05),
        "gla_w_out": nrm(ks[13], (N_GLA_LAYERS, GLA_VALUE_DIM, d), GLA_VALUE_DIM),
        "fnet_w_out": nrm(ks[14], (N_FNET_LAYERS, d, d), d),
        "ffn_w_gu": nrm(ks[15], (DEPTH, d, 2 * D_FF), d),
        "ffn_w_down": nrm(ks[16], (DEPTH, D_FF, d), D_FF),
    }


def reference(x, c, ctx, c_ctx, ada_w, ada_b, norm_gains, gla_w_in, gla_wg2_f, gla_bg_f, gla_wg2_b, gla_bg_b,
              gla_head_gain, gla_w_out, fnet_w_out, ffn_w_gu, ffn_w_down):
    rows = x.shape[1] // GRID_W
    s_lat = jax.nn.silu(c)
    s_ctx = jax.nn.silu(c_ctx)[None]
    for i in range(DEPTH):
        need_ctx = i < DEPTH - 1
        j = i // N_MIXERS
        is_gla = i % N_MIXERS == 0
        sh_m, sc_m, gt_m, sh_f, sc_f, gt_f = jnp.split((s_lat @ ada_w[i] + ada_b[i])[:, None, :], N_ADA, axis=-1)
        csh_m, csc_m, cgt_m, csh_f, csc_f, cgt_f = jnp.split((s_ctx @ ada_w[i] + ada_b[i])[:, None, :], N_ADA, axis=-1)

        h_lat = modulate(x, norm_gains[i, 0], sh_m, sc_m)
        if is_gla:
            h_ctx = modulate(ctx, norm_gains[i, 0], csh_m, csc_m)
            col_major = j % 2 == 1
            if col_major:
                h_lat = to_col_major(h_lat, rows)
            y_lat, y_ctx = gla_mix(h_lat, h_ctx, gla_w_in[j], gla_wg2_f[j], gla_bg_f[j], gla_wg2_b[j], gla_bg_b[j],
                                   gla_head_gain[j], gla_w_out[j], need_ctx)
            if col_major:
                y_lat = to_row_major(y_lat, rows)
        else:
            y_lat = fnet_mix(h_lat, fnet_w_out[j])
            y_ctx = fnet_mix(modulate(ctx, norm_gains[i, 0], csh_m, csc_m), fnet_w_out[j]) if need_ctx else None
        x = x + gt_m * rms_norm(y_lat, norm_gains[i, 1])

        f_lat = swiglu(modulate(x, norm_gains[i, 2], sh_f, sc_f), ffn_w_gu[i], ffn_w_down[i])
        x = x + gt_f * rms_norm(f_lat, norm_gains[i, 3])

        if need_ctx:
            ctx = ctx + cgt_m * rms_norm(y_ctx, norm_gains[i, 1])
            f_ctx = swiglu(modulate(ctx, norm_gains[i, 2], csh_f, csc_f), ffn_w_gu[i], ffn_w_down[i])
            ctx = ctx + cgt_f * rms_norm(f_ctx, norm_gains[i, 3])
    return x
```

```cpp
#include <hip/hip_runtime.h>
#include <cstdio>
#include <cstdint>

#ifndef FULL_MASK
#define FULL_MASK 0xFFFFFFFFu
#endif
#ifndef MK_N_LAUNCHES
#define MK_N_LAUNCHES 1
#endif
#ifndef PROBE_REP_MASK
#define PROBE_REP_MASK 0
#endif

constexpr int DM = 2048, BATCH = 2, SEQ = 4096, DEPTH = 4, CTXL = 256;
constexpr int NLAT = BATCH * SEQ, NCTX = BATCH * CTXL, MROWS = NLAT + NCTX;
constexpr int KD = 1024, VD = 2048, NH = 4, HK = 256, HV = 512, GR = 16;
constexpr int GIN = 2 * KD + 2 * VD + 2 * GR;
constexpr int GIN_PAD = 6400;
constexpr int DFF = 5632, NADA = 6 * DM;
constexpr float EPS = 1e-6f;
constexpr int NCHUNK = 68;
constexpr int NCG = BATCH * NCHUNK;

constexpr size_t al256(size_t x) { return (x + 255) & ~(size_t)255; }
constexpr size_t WS_CTL = 0, CTL_ZERO_BYTES = 65536;
constexpr size_t WS_MOD = WS_CTL + CTL_ZERO_BYTES;
constexpr size_t WS_WIN = al256(WS_MOD + (size_t)DEPTH * 3 * NADA * 4);
constexpr size_t WS_WGO = al256(WS_WIN + (size_t)2 * GIN_PAD * DM * 2);
constexpr size_t WS_WFO = al256(WS_WGO + (size_t)2 * DM * DM * 2);
constexpr size_t WS_WGU = al256(WS_WFO + (size_t)2 * DM * DM * 2);
constexpr size_t WS_WDN = al256(WS_WGU + (size_t)DEPTH * 2 * DFF * DM * 2);
constexpr size_t WS_DFTC = al256(WS_WDN + (size_t)DEPTH * DM * DFF * 2);
constexpr size_t WS_M1 = al256(WS_DFTC + (size_t)1024 * 512 * 2);
constexpr size_t WS_M2 = al256(WS_M1 + (size_t)64 * 128 * 128 * 2);
constexpr size_t WS_MC = al256(WS_M2 + (size_t)64 * 128 * 2);
constexpr size_t WS_XA = al256(WS_MC + (size_t)256 * 512 * 2);
constexpr size_t WS_H = al256(WS_XA + (size_t)MROWS * DM * 4);
constexpr size_t WS_Q = al256(WS_H + (size_t)MROWS * DM * 2);
constexpr size_t WS_K = al256(WS_Q + (size_t)MROWS * KD * 2);
constexpr size_t WS_V = al256(WS_K + (size_t)MROWS * KD * 2);
constexpr size_t WS_R = al256(WS_V + (size_t)MROWS * VD * 2);
constexpr size_t WS_LR = al256(WS_R + (size_t)MROWS * VD * 2);
constexpr size_t WS_QD = al256(WS_LR + (size_t)MROWS * 32 * 4);
constexpr size_t WS_KET = al256(WS_QD + (size_t)2 * MROWS * KD * 2);
constexpr size_t WS_VT = al256(WS_KET + (size_t)2 * NCG * NH * HK * 64 * 2);
constexpr size_t WS_AM = al256(WS_VT + (size_t)NCG * VD * 64 * 2);
constexpr size_t WS_DEC = al256(WS_AM + (size_t)2 * NCG * NH * 64 * 64 * 2);
constexpr size_t WS_O = al256(WS_DEC + (size_t)2 * NCG * NH * HK * 4);
constexpr size_t WS_Y = al256(WS_O + (size_t)2 * MROWS * VD * 2);
constexpr size_t WS_ACT = al256(WS_Y + (size_t)MROWS * DM * 2);
constexpr size_t WS_UC = al256(WS_ACT + (size_t)MROWS * DFF * 2);
constexpr size_t WS_T = al256(WS_UC + (size_t)MROWS * 4096 * 2);
constexpr size_t WS_END = al256(WS_T + (size_t)NLAT * 4096 * 2);
constexpr int CW_BAR = 1024;

constexpr int RING_BYTES = 131072;
constexpr int LDS_BYTES = 163840;
constexpr int MISC_OFF = LDS_BYTES - 512;
constexpr int NWAVES = 8;

#define GAS __attribute__((address_space(1)))
#define LAS __attribute__((address_space(3)))
typedef unsigned short bf16;
typedef unsigned v4u __attribute__((ext_vector_type(4)));
typedef unsigned v2u __attribute__((ext_vector_type(2)));
typedef float f32x4 __attribute__((ext_vector_type(4)));
typedef short bf16x8 __attribute__((ext_vector_type(8)));
typedef short s16x4 __attribute__((ext_vector_type(4)));
#define RLX_AGENT __ATOMIC_RELAXED, __HIP_MEMORY_SCOPE_AGENT
#define LDS_WAIT() asm volatile("s_waitcnt lgkmcnt(0)" ::: "memory")
#define VM_WAIT() asm volatile("s_waitcnt vmcnt(0)" ::: "memory")
#define DI __device__ __forceinline__

DI unsigned f2bf(float f) { unsigned u = __builtin_bit_cast(unsigned, f); return (u + 0x7fffu + ((u >> 16) & 1u)) >> 16; }
typedef float f32x2_t __attribute__((ext_vector_type(2))); typedef __bf16 bf16x2_t __attribute__((ext_vector_type(2)));
DI unsigned pk2(float lo, float hi) { f32x2_t v = {lo, hi}; bf16x2_t b = __builtin_convertvector(v, bf16x2_t); return __builtin_bit_cast(unsigned, b); }
DI float bf2f(unsigned short b) { return __builtin_bit_cast(float, (unsigned)b << 16); }
DI float bflo(unsigned w) { return __builtin_bit_cast(float, w << 16); }
DI float bfhi(unsigned w) { return __builtin_bit_cast(float, w & 0xffff0000u); }
DI float wave_sum(float v) {
#pragma unroll
    for (int o = 1; o < 64; o <<= 1) v += __shfl_xor(v, o);
    return v;
}
DI float silu_f(float x) { return x * __builtin_amdgcn_rcpf(1.0f + __expf(-x)); }
DI bf16x8 ld_frag_g(const bf16* p) { return *(const GAS bf16x8*)p; }
DI bf16x8 ld_frag_l(const LAS unsigned char* p) { return *(const LAS bf16x8*)p; }
DI s16x4 vtr(const LAS unsigned char* p) { return __builtin_bit_cast(s16x4, __builtin_amdgcn_ds_read_tr16_b64_v4i16((LAS s16x4*)p)); }
DI f32x4 mfma16(bf16x8 a, bf16x8 b, f32x4 c) { return __builtin_amdgcn_mfma_f32_16x16x32_bf16(a, b, c, 0, 0, 0); }

namespace pg8 {
#define PG8_LAS __attribute__((address_space(3)))
typedef unsigned short bf16_t;
typedef unsigned u32x4 __attribute__((ext_vector_type(4)));
typedef unsigned u32x2 __attribute__((ext_vector_type(2)));
constexpr int BM = 256, BK = 64, HALF = 128, HTB = HALF * BK * 2, STAGE_BYTES = 8 * HTB, NXCD = 8, WGM = 8, PMS = 272;
constexpr int XOFF = 132096;
__host__ __device__ __forceinline__ int lds_byte(int r, int c) { const int st = (r >> 4) * 2 + (c >> 5), rr = r & 15, cc = c & 31, ob = rr * 64 + cc * 2; return st * 1024 + (ob ^ (((ob >> 9) & 1) << 5)); }
__host__ __device__ __forceinline__ void stage_rc(int b, int& R, int& C) { const int st = b / 1024, sb = b % 1024, swz = sb ^ (((sb >> 9) & 1) << 5); R = (st >> 1) * 16 + swz / 64; C = (st & 1) * 32 + (swz % 64) / 2; }
__host__ __device__ __forceinline__ int perm32(int rho) { const int n = rho >> 4, i = rho & 15; return 8 * (i >> 2) + 4 * n + (i & 3); }
struct Unit { int pm, pn; };
struct Gemm { const bf16_t* A; const bf16_t* Bt; int K, lda, ldb, npg, pms; };
struct StaticOrder {
    int nM, nN, nwg, G, c;
    __host__ __device__ void init(int nM_, int nN_, int G_, int c_) { nM = nM_; nN = nN_; nwg = nM * nN; G = G_; c = c_; }
    __host__ __device__ bool next(int i, Unit& u) const {
        const long L = (long)i * G + c; if (L >= nwg) return false;
        int wgid = (int)L; { const int q = nwg / NXCD, r = nwg % NXCD, xcd = wgid % NXCD, off = wgid / NXCD; wgid = (xcd < r ? xcd * (q + 1) : r * (q + 1) + (xcd - r) * q) + off; }
        const int nig = WGM * nN, gid = wgid / nig, fm = gid * WGM, gsz = (nM - fm) < WGM ? (nM - fm) : WGM;
        u.pm = fm + ((wgid % nig) % gsz); u.pn = (wgid % nig) / gsz; return true;
    }
    __device__ __forceinline__ void a_ready(const Unit&) const {}
    __device__ __forceinline__ void done(const Unit&) const {}
};
__device__ __forceinline__ unsigned cvt_pk_bf16(float lo, float hi) { unsigned r; asm volatile("v_cvt_pk_bf16_f32 %0, %1, %2" : "=v"(r) : "v"(lo), "v"(hi)); return r; }

struct EpiBf16 {
    static constexpr bool PERM = true;
    bf16_t* O; int ldc, pms;
    __device__ __forceinline__ void operator()(const f32x4 (&acc)[2][2][4][2], const f32x4 (&accx)[2], const Unit& u, int wr, int wc, int fr, int fq) const {
        const int row0 = u.pm * pms + wr * 64 + fr, col0 = u.pn * BM + wc * 32 + 8 * fq;
#pragma unroll
        for (int ai = 0; ai < 2; ++ai)
#pragma unroll
            for (int m = 0; m < 4; ++m) { bf16_t* rowp = O + (size_t)(row0 + ai * HALF + m * 16) * ldc + col0;
#pragma unroll
                for (int bj = 0; bj < 2; ++bj) { const f32x4 v0 = acc[ai][bj][m][0], v1 = acc[ai][bj][m][1];
                    u32x4 w; w.x = cvt_pk_bf16(v0[0], v0[1]); w.y = cvt_pk_bf16(v0[2], v0[3]); w.z = cvt_pk_bf16(v1[0], v1[1]); w.w = cvt_pk_bf16(v1[2], v1[3]);
                    *(GAS u32x4*)(rowp + bj * HALF) = w; } }
        if (pms == BM) return;
        bf16_t* xrow = O + (size_t)(u.pm * pms + 256 + fr) * ldc + col0 + 4 * wr;
#pragma unroll
        for (int bj = 0; bj < 2; ++bj) { u32x2 w; w.x = cvt_pk_bf16(accx[bj][0], accx[bj][1]); w.y = cvt_pk_bf16(accx[bj][2], accx[bj][3]); *(GAS u32x2*)(xrow + bj * HALF) = w; }
    }
};
struct EpiWin {
    static constexpr bool PERM = true;
    bf16_t *Q, *K, *V, *R; int pms;
    __device__ __forceinline__ void operator()(const f32x4 (&acc)[2][2][4][2], const f32x4 (&accx)[2], const Unit& u, int wr, int wc, int fr, int fq) const {
        const int row0 = u.pm * pms + wr * 64 + fr; const int pn = u.pn;
        bf16_t* base; int ldc, colt; float sc = 1.0f;
        if (pn < 4) { base = Q; ldc = KD; colt = pn * BM; sc = 0.0625f; }
        else if (pn < 8) { base = K; ldc = KD; colt = (pn - 4) * BM; }
        else if (pn < 16) { base = V; ldc = VD; colt = (pn - 8) * BM; }
        else { base = R; ldc = VD; colt = (pn - 16) * BM; }
        const int col0 = colt + wc * 32 + 8 * fq;
#pragma unroll
        for (int ai = 0; ai < 2; ++ai)
#pragma unroll
            for (int m = 0; m < 4; ++m) { bf16_t* rowp = base + (size_t)(row0 + ai * HALF + m * 16) * ldc + col0;
#pragma unroll
                for (int bj = 0; bj < 2; ++bj) { const f32x4 v0 = acc[ai][bj][m][0] * sc, v1 = acc[ai][bj][m][1] * sc;
                    u32x4 w; w.x = cvt_pk_bf16(v0[0], v0[1]); w.y = cvt_pk_bf16(v0[2], v0[3]); w.z = cvt_pk_bf16(v1[0], v1[1]); w.w = cvt_pk_bf16(v1[2], v1[3]);
                    *(GAS u32x4*)(rowp + bj * HALF) = w; } }
        if (pms == BM) return;
        bf16_t* xrow = base + (size_t)(u.pm * pms + 256 + fr) * ldc + col0 + 4 * wr;
#pragma unroll
        for (int bj = 0; bj < 2; ++bj) { const f32x4 v = accx[bj] * sc; u32x2 w; w.x = cvt_pk_bf16(v[0], v[1]); w.y = cvt_pk_bf16(v[2], v[3]); *(GAS u32x2*)(xrow + bj * HALF) = w; }
    }
};
struct EpiSwiglu {
    static constexpr bool PERM = true;
    bf16_t* O; int ldc, pms;
    __device__ __forceinline__ void operator()(const f32x4 (&acc)[2][2][4][2], const f32x4 (&accx)[2], const Unit& u, int wr, int wc, int fr, int fq) const {
        const int row0 = u.pm * pms + wr * 64 + fr, col0 = u.pn * HALF + wc * 32 + 8 * fq;
#pragma unroll
        for (int ai = 0; ai < 2; ++ai)
#pragma unroll
            for (int m = 0; m < 4; ++m) { bf16_t* rowp = O + (size_t)(row0 + ai * HALF + m * 16) * ldc + col0;
                f32x4 v0, v1;
#pragma unroll
                for (int j = 0; j < 4; ++j) { const float g0 = acc[ai][0][m][0][j], g1 = acc[ai][0][m][1][j];
                    v0[j] = g0 * __builtin_amdgcn_rcpf(1.0f + __expf(-g0)) * acc[ai][1][m][0][j];
                    v1[j] = g1 * __builtin_amdgcn_rcpf(1.0f + __expf(-g1)) * acc[ai][1][m][1][j]; }
                u32x4 w; w.x = cvt_pk_bf16(v0[0], v0[1]); w.y = cvt_pk_bf16(v0[2], v0[3]); w.z = cvt_pk_bf16(v1[0], v1[1]); w.w = cvt_pk_bf16(v1[2], v1[3]);
                *(GAS u32x4*)(rowp) = w; }
        if (pms == BM) return;
        f32x4 v;
#pragma unroll
        for (int j = 0; j < 4; ++j) { const float g0 = accx[0][j]; v[j] = g0 * __builtin_amdgcn_rcpf(1.0f + __expf(-g0)) * accx[1][j]; }
        u32x2 w; w.x = cvt_pk_bf16(v[0], v[1]); w.y = cvt_pk_bf16(v[2], v[3]);
        *(GAS u32x2*)(O + (size_t)(u.pm * pms + 256 + fr) * ldc + col0 + 4 * wr) = w;
    }
};

struct EpiSwigluH {
    static constexpr bool PERM = true;
    bf16_t* O; int ldc;
    __device__ __forceinline__ void operator()(const f32x4 (&acc)[2][2][4][2], const f32x4 (&)[2], const Unit& u, int wr, int wc, int fr, int fq) const {
        const int row0 = u.pm * HALF + wr * 64 + fr, col0 = u.pn * HALF + wc * 32 + 8 * fq;
#pragma unroll
        for (int m = 0; m < 4; ++m) { bf16_t* rowp = O + (size_t)(row0 + m * 16) * ldc + col0;
            f32x4 v0, v1;
#pragma unroll
            for (int j = 0; j < 4; ++j) { const float g0 = acc[0][0][m][0][j], g1 = acc[0][0][m][1][j];
                v0[j] = g0 * __builtin_amdgcn_rcpf(1.0f + __expf(-g0)) * acc[0][1][m][0][j];
                v1[j] = g1 * __builtin_amdgcn_rcpf(1.0f + __expf(-g1)) * acc[0][1][m][1][j]; }
            u32x4 w; w.x = cvt_pk_bf16(v0[0], v0[1]); w.y = cvt_pk_bf16(v0[2], v0[3]); w.z = cvt_pk_bf16(v1[0], v1[1]); w.w = cvt_pk_bf16(v1[2], v1[3]);
            *(GAS u32x4*)(rowp) = w; }
    }
};

__device__ __forceinline__ void glds16_s(unsigned voff, const void* sbase, unsigned lds_dst) { unsigned keep;
    asm volatile("s_mov_b32 %0, m0\n\ts_mov_b32 m0, %3\n\ts_nop 0\n\tglobal_load_lds_dwordx4 %1, %2\n\ts_mov_b32 m0, %0" : "=&s"(keep) : "v"(voff), "s"(sbase), "s"(lds_dst) : "memory"); }
template <class Epi, class Sched, bool HM = false>
__device__ __forceinline__ void gemm_phase(PG8_LAS unsigned char* lds, const Gemm g, const Sched& S, const Epi& E) {
    int tid_ = threadIdx.x; asm volatile("; launder tid" : "+v"(tid_));
    const int tid = tid_, wid = __builtin_amdgcn_readfirstlane(tid >> 6), lane = tid & 63, wr = wid >> 2, wc = wid & 3, fr = lane & 15, fq = lane >> 4;
    const int K = g.K, nt = K / BK;
    unsigned voffA[2], voffB[2];
#pragma unroll
    for (int i = 0; i < 2; ++i) { int R, C; stage_rc(tid * 16 + i * 8192, R, C); const int Rb = Epi::PERM ? ((R & ~31) + perm32(R & 31)) : R;
        voffA[i] = (unsigned)(R * g.lda + C) * 2u; voffB[i] = (unsigned)(Rb * g.ldb + C) * 2u; }
    const unsigned voffX = (unsigned)((4 * (wid & 3) + (lane >> 4)) * g.lda + 8 * (lane & 15)) * 2u;
    const size_t kstep = (size_t)(BK * 2);
    const size_t hstepA = (size_t)HALF * g.lda * 2, hstepB = (size_t)HALF * g.ldb * 2;
    const size_t tstepA = (size_t)(HM ? HALF : g.pms) * g.lda * 2, tstepB = 2 * hstepB, xstep = 2 * hstepA; const bool hasx = g.pms != BM;
    const unsigned ldsw = (unsigned)wid * 1024u, ldsx = (unsigned)(wid & 3) * 1024u;
    const unsigned ldsbase = (unsigned)__builtin_amdgcn_readfirstlane((int)(unsigned)(__UINTPTR_TYPE__)lds);
    const int aoff = lds_byte(wr * 64 + fr, fq * 8), boff = lds_byte(wc * 32 + fr, fq * 8);
    const int xoff = XOFF + fr * 256 + fq * 16;
#define PG8_SA(b, h) (((b) * 2 + (h)) * HTB)
#define PG8_SB(b, h) ((4 + (b) * 2 + (h)) * HTB)
#define PG8_STAGE(bufoff, gbase, voff) do { _Pragma("unroll") for (int _i = 0; _i < 2; ++_i) glds16_s((voff)[_i], (const void*)(gbase), ldsbase + (unsigned)((bufoff) + _i * 8192) + ldsw); } while (0)
#define PG8_STAGEX(pb, gbase) glds16_s(voffX, (const void*)(gbase), ldsbase + (unsigned)(XOFF + (pb) * 4096) + ldsx)
#define PG8_LDA(dst, b, h) do { _Pragma("unroll") for (int m = 0; m < 4; ++m) _Pragma("unroll") for (int k = 0; k < 2; ++k) dst[m][k] = *(const PG8_LAS bf16x8*)(lds + PG8_SA(b, h) + aoff + m * 2048 + k * 1024); } while (0)
#define PG8_LDB(dst, b, h) do { _Pragma("unroll") for (int n = 0; n < 2; ++n) _Pragma("unroll") for (int k = 0; k < 2; ++k) dst[n][k] = *(const PG8_LAS bf16x8*)(lds + PG8_SB(b, h) + boff + n * 2048 + k * 1024); } while (0)
#define PG8_LDX(pb, tp) do { _Pragma("unroll") for (int k = 0; k < 2; ++k) Ax[k] = *(const PG8_LAS bf16x8*)(lds + xoff + (pb) * 4096 + (tp) * 128 + k * 64); } while (0)
#define PG8_MMA(ai, bj, At, Bt) do { __builtin_amdgcn_s_setprio(1); _Pragma("unroll") for (int m = 0; m < 4; ++m) _Pragma("unroll") for (int n = 0; n < 2; ++n) _Pragma("unroll") for (int k = 0; k < 2; ++k) \
        acc[ai][bj][m][n] = __builtin_amdgcn_mfma_f32_16x16x32_bf16(Bt[n][k], At[m][k], acc[ai][bj][m][n], 0, 0, 0); __builtin_amdgcn_s_setprio(0); } while (0)
#define PG8_MMAX() do { if (wr) { _Pragma("unroll") for (int k = 0; k < 2; ++k) { \
        accx[0] = __builtin_amdgcn_mfma_f32_16x16x32_bf16(B0[1][k], Ax[k], accx[0], 0, 0, 0); accx[1] = __builtin_amdgcn_mfma_f32_16x16x32_bf16(B1[1][k], Ax[k], accx[1], 0, 0, 0); } } \
    else { _Pragma("unroll") for (int k = 0; k < 2; ++k) { \
        accx[0] = __builtin_amdgcn_mfma_f32_16x16x32_bf16(B0[0][k], Ax[k], accx[0], 0, 0, 0); accx[1] = __builtin_amdgcn_mfma_f32_16x16x32_bf16(B1[0][k], Ax[k], accx[1], 0, 0, 0); } } } while (0)
#define PG8_WAIT_V(n) asm volatile("s_waitcnt vmcnt(" #n ")" ::: "memory")
#define PG8_WAIT_L(n) asm volatile("s_waitcnt lgkmcnt(" #n ")" ::: "memory")
#define PG8_BAR __builtin_amdgcn_s_barrier()
#define PG8_SCHED __builtin_amdgcn_sched_barrier(0)
#define PG8_APTR(u) ((const char*)g.A + (size_t)(u).pm * tstepA + (size_t)((u).pn / g.npg) * K * 2)
#define PG8_BPTR(u) ((const char*)g.Bt + (size_t)((u).pn % g.npg) * tstepB)
    Unit cur, nxt; int ui = 0;
    if (!S.next(0, cur)) return;
    f32x4 acc[2][2][4][2]; f32x4 accx[2];
#pragma unroll
    for (int a = 0; a < 2; ++a)
#pragma unroll
        for (int b = 0; b < 2; ++b)
#pragma unroll
            for (int m = 0; m < 4; ++m)
#pragma unroll
                for (int n = 0; n < 2; ++n) acc[a][b][m][n] = (f32x4){0.f, 0.f, 0.f, 0.f};
    accx[0] = (f32x4){0.f, 0.f, 0.f, 0.f}; accx[1] = accx[0];
    bf16x8 At[4][2], B0[2][2], B1[2][2], Ax[2];
    const char* cA = PG8_APTR(cur); const char* cB = PG8_BPTR(cur);
    S.a_ready(cur);
    PG8_STAGE(PG8_SB(0, 0), cB, voffB); PG8_STAGE(PG8_SB(0, 1), cB + hstepB, voffB); PG8_STAGE(PG8_SA(0, 0), cA, voffA); PG8_STAGEX(0, cA + xstep); PG8_STAGE(PG8_SA(0, 1), cA + hstepA, voffA);
    if (wr == 1) PG8_BAR;
    PG8_WAIT_V(2); PG8_BAR;
    PG8_STAGE(PG8_SB(1, 0), cB + kstep, voffB); PG8_STAGE(PG8_SA(1, 0), cA + kstep, voffA); PG8_STAGE(PG8_SB(1, 1), cB + hstepB + kstep, voffB);
    PG8_WAIT_V(6); PG8_BAR;
    for (;;) {
        const bool has_next = S.next(ui + 1, nxt);
        const char* nA = has_next ? PG8_APTR(nxt) : cA; const char* nB = has_next ? PG8_BPTR(nxt) : cB;
        for (int t = 0; t < nt; t += 2) {
            const bool last = (t == nt - 2);
            const char* a1 = cA + (size_t)(t + 1) * kstep;
            const char* a2 = last ? nA : cA + (size_t)(t + 2) * kstep; const char* b2 = last ? nB : cB + (size_t)(t + 2) * kstep;
            const char* a3 = a2 + kstep; const char* b3 = b2 + kstep;
            asm volatile("; uniform bases" : "+s"(a1), "+s"(a2), "+s"(a3), "+s"(b2), "+s"(b3));
            if (last && has_next) S.a_ready(nxt);
            const int pb = (t >> 1) & 1;
            PG8_LDB(B0, 0, 0); PG8_LDB(B1, 0, 1); PG8_SCHED; PG8_LDA(At, 0, 0); if (hasx) PG8_LDX(pb, 0); PG8_STAGE(PG8_SA(1, 1), a1 + hstepA, voffA); PG8_STAGEX(pb ^ 1, a2 + xstep);
            PG8_WAIT_V(9); PG8_WAIT_L(0); PG8_BAR; PG8_MMA(0, 0, At, B0); PG8_MMA(0, 1, At, B1); if (hasx) PG8_MMAX(); PG8_BAR; PG8_SCHED;
            if (!HM) PG8_LDA(At, 0, 1); PG8_STAGE(PG8_SB(0, 0), b2, voffB); PG8_STAGE(PG8_SB(0, 1), b2 + hstepB, voffB); PG8_STAGE(PG8_SA(0, 0), a2, voffA);
            PG8_WAIT_V(9); PG8_WAIT_L(0); PG8_BAR; if (!HM) { PG8_MMA(1, 0, At, B0); PG8_MMA(1, 1, At, B1); } PG8_BAR; PG8_SCHED;
            PG8_LDB(B0, 1, 0); PG8_LDB(B1, 1, 1); PG8_SCHED; PG8_LDA(At, 1, 0); if (hasx) PG8_LDX(pb, 1); PG8_STAGE(PG8_SA(0, 1), a2 + hstepA, voffA);
            PG8_WAIT_V(9); PG8_WAIT_L(0); PG8_BAR; PG8_MMA(0, 0, At, B0); PG8_MMA(0, 1, At, B1); if (hasx) PG8_MMAX(); PG8_BAR; PG8_SCHED;
            if (!HM) PG8_LDA(At, 1, 1); PG8_STAGE(PG8_SB(1, 0), b3, voffB); PG8_STAGE(PG8_SB(1, 1), b3 + hstepB, voffB); PG8_STAGE(PG8_SA(1, 0), a3, voffA);
            PG8_WAIT_V(8); PG8_WAIT_L(0); PG8_BAR; if (!HM) { PG8_MMA(1, 0, At, B0); PG8_MMA(1, 1, At, B1); } PG8_BAR; PG8_SCHED;
        }
        if (wr == 0) PG8_BAR;
        E(acc, accx, cur, wr, wc, fr, fq); S.done(cur);
        if (!has_next) break;
#pragma unroll
        for (int a = 0; a < 2; ++a)
#pragma unroll
            for (int b = 0; b < 2; ++b)
#pragma unroll
                for (int m = 0; m < 4; ++m)
#pragma unroll
                    for (int n = 0; n < 2; ++n) acc[a][b][m][n] = (f32x4){0.f, 0.f, 0.f, 0.f};
        accx[0] = (f32x4){0.f, 0.f, 0.f, 0.f}; accx[1] = accx[0];
        cur = nxt; cA = nA; cB = nB; ++ui;
        if (wr == 1) PG8_BAR;
    }
    PG8_WAIT_V(0);
    PG8_BAR;
#undef PG8_SA
#undef PG8_SB
#undef PG8_STAGE
#undef PG8_STAGEX
#undef PG8_LDA
#undef PG8_LDB
#undef PG8_LDX
#undef PG8_MMA
#undef PG8_MMAX
#undef PG8_WAIT_V
#undef PG8_WAIT_L
#undef PG8_BAR
#undef PG8_SCHED
#undef PG8_APTR
#undef PG8_BPTR
}
}

#define XB_TMO      128
#define XB_XCNT(j)  (256  + 64 * (j))
#define XB_XSUB(j)  (1280 + 64 * (j))
#define XB_XGEN(j)  (2304 + 64 * (j))
#define XB_TOP      3328
#define XB_TOPGEN   3392
#define XCD_BAR_WORDS 3456
#define XB_SPIN_CAP (1u << 18)
__device__ __forceinline__ unsigned xb_ld(unsigned* p)              { return __hip_atomic_load(p, __ATOMIC_RELAXED, __HIP_MEMORY_SCOPE_AGENT); }
__device__ __forceinline__ unsigned xb_add(unsigned* p, unsigned v) { return __hip_atomic_fetch_add(p, v, __ATOMIC_RELAXED, __HIP_MEMORY_SCOPE_AGENT); }
__device__ __forceinline__ unsigned xb_xcc_id() { return (unsigned)__builtin_amdgcn_s_getreg((3 << 11) | 20) & 0xFu; }
#define XB_SPIN(cond, bar) do { unsigned _sp = 0; while (cond) { __builtin_amdgcn_s_sleep(1); \
    if ((++_sp & 255u) == 0u) { if (xb_ld(&(bar)[XB_TMO])) break; if (_sp > XB_SPIN_CAP) { atomicAdd(&(bar)[XB_TMO], 1u); break; } } } } while (0)
struct XcdBarrier { unsigned* bar; unsigned x; volatile LAS unsigned* st; };
__device__ __forceinline__ XcdBarrier xcd_barrier_post(unsigned* bar, volatile LAS unsigned* st) {
    XcdBarrier b; b.bar = bar; b.x = xb_xcc_id(); b.st = st;
    if (threadIdx.x == 0) (void)xb_add(&bar[XB_XCNT(b.x)], 1u);
    return b;
}
__device__ __forceinline__ void xcd_barrier_complete(unsigned* bar, unsigned x, unsigned& nloc, unsigned& nx) {
    const unsigned G = gridDim.x * gridDim.y * gridDim.z;
    unsigned sum, cnt, mine, sp = 0u;
    for (;;) {
        sum = 0u; cnt = 0u; mine = 0u;
#pragma unroll
        for (unsigned j = 0; j < 16; ++j) { const unsigned c = xb_ld(&bar[XB_XCNT(j)]); sum += c; cnt += (c > 0u) ? 1u : 0u; mine = (j == x) ? c : mine; }
        if (sum == G) break;
        __builtin_amdgcn_s_sleep(1);
        if ((++sp & 255u) == 0u) { if (xb_ld(&bar[XB_TMO])) break; if (sp > XB_SPIN_CAP) { atomicAdd(&bar[XB_TMO], 1u); break; } }
    }
    nloc = mine > 0u ? mine : 1u; nx = cnt > 0u ? cnt : 1u;
}
__device__ __forceinline__ void xcd_barrier(const XcdBarrier& b) {
    asm volatile("s_waitcnt vmcnt(0)" ::: "memory");
    __syncthreads();
    if (threadIdx.x == 0) {
        unsigned* bar = b.bar;
        __builtin_amdgcn_s_waitcnt(0);
        unsigned nloc = b.st[0], nx = b.st[1];
        if (nloc == 0u) { xcd_barrier_complete(bar, b.x, nloc, nx); b.st[0] = nloc; b.st[1] = nx; }
        const unsigned old = xb_add(&bar[XB_XSUB(b.x)], 1u);
        const unsigned gen = old / nloc;
        if (old + 1u == (gen + 1u) * nloc) {
            __builtin_amdgcn_fence(__ATOMIC_RELEASE, "agent");
            asm volatile("s_waitcnt vmcnt(0)" ::: "memory");
            const unsigned og = xb_add(&bar[XB_TOP], 1u);
            const unsigned tg = og / nx;
            if (og + 1u == (tg + 1u) * nx) xb_add(&bar[XB_TOPGEN], 1u);
            else XB_SPIN(xb_ld(&bar[XB_TOPGEN]) == tg, bar);
            __builtin_amdgcn_fence(__ATOMIC_ACQUIRE, "agent");
            xb_add(&bar[XB_XGEN(b.x)], 1u);
            asm volatile("s_waitcnt vmcnt(0)" ::: "memory");
        } else {
            XB_SPIN(xb_ld(&bar[XB_XGEN(b.x)]) == gen, bar);
            __builtin_amdgcn_fence(__ATOMIC_ACQUIRE, "agent");
            asm volatile("s_waitcnt vmcnt(0)" ::: "memory");
        }
    }
    __syncthreads();
}

struct Args {
    const float *x, *c, *ctx, *c_ctx, *ada_w, *ada_b, *norm_gains, *gla_w_in, *gla_wg2_f, *gla_bg_f, *gla_wg2_b, *gla_bg_b, *gla_head_gain, *gla_w_out, *fnet_w_out, *ffn_w_gu, *ffn_w_down;
    float* out; unsigned char* ws; int ph_lo, ph_hi, rep_mask, pad;
};
struct Frame {
    LAS unsigned char* lds;
    int tid, lane, wave, vcu, G;
};

DI unsigned char* launder_ptr(unsigned char* p) { asm volatile("; launder ptr" : "+s"(p)); return p; }
DI Frame launder(const Frame& F0) { Frame F = F0; asm volatile("; launder frame" : "+v"(F.tid), "+v"(F.lane), "+s"(F.wave), "+s"(F.vcu)); return F; }
DI int row_mb(int R) { return R < SEQ ? 0 : (R < NLAT ? 1 : 2); }

DI int fnet_chan(int p) { return p <= 256 ? p : 768 - p; }
DI void transpose_item(const float* W, int K, int N, bf16* WT, int k0, int n0, int drow0, LAS float* scr, int lane, int perm = 0) {
#pragma unroll
    for (int i = 0; i < 32; ++i) { const int kk = 2 * i + (lane >> 5); const int k = k0 + kk, kr = perm ? ((k & ~511) | fnet_chan(k & 511)) : k;
        scr[kk * 33 + (lane & 31)] = __builtin_nontemporal_load(W + (size_t)kr * N + n0 + (lane & 31)); }
    LDS_WAIT(); asm volatile("" ::: "memory");
    const int c = lane & 7;
#pragma unroll
    for (int j = 0; j < 4; ++j) { const int n = (lane >> 3) + 8 * j; const LAS float* s = scr + (8 * c) * 33 + n;
        v4u o; o.x = pk2(s[0 * 33], s[1 * 33]); o.y = pk2(s[2 * 33], s[3 * 33]); o.z = pk2(s[4 * 33], s[5 * 33]); o.w = pk2(s[6 * 33], s[7 * 33]);
        __builtin_nontemporal_store(o, (GAS v4u*)(WT + (size_t)(drow0 + n) * K + k0 + 8 * c)); }
    LDS_WAIT(); asm volatile("" ::: "memory");
}

DI void phase_prologue(const Frame& F0, const Args& a) {
    const Frame F = launder(F0);
    unsigned char* ws = launder_ptr(a.ws);
    {
        LAS float* sv = (LAS float*)(F.lds);
        LAS float* red = (LAS float*)(F.lds + 24576);
        for (int i = F.tid; i < 3 * DM; i += 512) { const int mb = i / DM, k = i % DM; const float cv = mb < 2 ? a.c[mb * DM + k] : a.c_ctx[k]; sv[i] = cv / (1.0f + __expf(-cv)); }
        __syncthreads();
        float* mod = (float*)(ws + WS_MOD);
        for (int unit = F.vcu; unit < DEPTH * 64; unit += F.G) {
            const int li = unit >> 6, cb = unit & 63, n0 = cb * 192;
            const float* W = a.ada_w + (size_t)li * DM * NADA + n0;
            f32x4 acc0 = {0.f, 0.f, 0.f, 0.f}, acc1 = acc0, acc2 = acc0;
            if (F.lane < 48) {
                const int kb = F.wave * 256;
#pragma unroll 16
                for (int k = 0; k < 256; ++k) {
                    const f32x4 w = __builtin_nontemporal_load((const GAS f32x4*)(W + (size_t)(kb + k) * NADA + F.lane * 4));
                    const float s0 = sv[kb + k], s1 = sv[DM + kb + k], s2 = sv[2 * DM + kb + k];
                    acc0 += w * s0; acc1 += w * s1; acc2 += w * s2;
                }
                *(LAS f32x4*)(red + (F.wave * 3 + 0) * 192 + F.lane * 4) = acc0;
                *(LAS f32x4*)(red + (F.wave * 3 + 1) * 192 + F.lane * 4) = acc1;
                *(LAS f32x4*)(red + (F.wave * 3 + 2) * 192 + F.lane * 4) = acc2;
            }
            __syncthreads();
            for (int o = F.tid; o < 3 * 192; o += 512) { const int mb = o / 192, cidx = o % 192; float s = a.ada_b[(size_t)li * NADA + n0 + cidx];
#pragma unroll
                for (int w = 0; w < 8; ++w) s += red[(w * 3 + mb) * 192 + cidx];
                const int n = n0 + cidx, ch = n >> 11, col = n & (DM - 1); const float* gl = a.norm_gains + (size_t)li * 4 * DM;
                if (ch == 1) s = gl[col] * (1.0f + s); else if (ch == 2) s = gl[DM + col] * s; else if (ch == 4) s = gl[2 * DM + col] * (1.0f + s); else if (ch == 5) s = gl[3 * DM + col] * s;
                *(GAS float*)(mod + ((size_t)li * 3 + mb) * NADA + n) = s; }
            __syncthreads();
        }
    }
    {
        const int gt = F.vcu * 512 + F.tid, NT = F.G * 512;
        bf16* dftc = (bf16*)(ws + WS_DFTC); bf16* m1 = (bf16*)(ws + WS_M1); bf16* m2 = (bf16*)(ws + WS_M2); bf16* mc = (bf16*)(ws + WS_MC);
        for (int i = gt; i < 512 * 512; i += NT) { const int n = i >> 9, cidx = i & 511, part = n >> 8, m = n & 255; float s, c; sincospif(2.0f * (float)((cidx * m) & 511) / 512.0f, &s, &c);
            *(GAS bf16*)(dftc + i) = (bf16)f2bf(part == 0 ? c : (m == 0 ? ((cidx & 1) ? -1.0f : 1.0f) : -s)); }
        for (int i = gt; i < 64 * 128 * 64; i += NT) { const int n2 = i >> 13, r = (i >> 6) & 127, n1 = i & 63, qq = r >> 6, k1 = r & 63;
            float s, c; sincospif(2.0f * (float)((k1 * (64 * n1 + n2)) & 4095) / 4096.0f, &s, &c); *(GAS bf16*)(m1 + i) = (bf16)f2bf(qq ? s : c); }
        for (int i = gt; i < 64 * 128; i += NT) { const int k2 = i >> 7, cc = i & 127, pi = cc >> 6, n2 = cc & 63; float s, c; sincospif(2.0f * (float)((k2 * n2) & 63) / 64.0f, &s, &c); *(GAS bf16*)(m2 + i) = (bf16)f2bf(pi ? s : c); }
        for (int i = gt; i < 256 * 512; i += NT) { const int k = i >> 9, cc = i & 511, pi = cc >> 8, n = cc & 255; float s, c; sincospif(2.0f * (float)((k * n) & 255) / 256.0f, &s, &c); *(GAS bf16*)(mc + i) = (bf16)f2bf(pi ? s : c); }
    }
    {
        LAS float* scr = (LAS float*)(F.lds + 43008 + F.wave * 8448);
        const int gw = F.vcu * NWAVES + F.wave, NGW = F.G * NWAVES;
        constexpr int I_IN = 32 * (GIN / 32), I_SQ = 32 * 64, I_GU = 32 * (2 * DFF / 32), I_DN = (DFF / 64) * 64;
        constexpr int NITEMS = 2 * I_IN + 2 * I_SQ + 2 * I_SQ + DEPTH * I_GU + DEPTH * I_DN;
        for (int it = gw; it < NITEMS; it += NGW) {
            int r = it;
            if (r < 2 * I_IN) { const int j = r / I_IN; r %= I_IN; const int nblk = GIN / 32, kb = r / nblk, nb = r % nblk;
                transpose_item(a.gla_w_in + (size_t)j * DM * GIN, DM, GIN, (bf16*)(ws + WS_WIN) + (size_t)j * GIN_PAD * DM, 64 * kb, 32 * nb, 32 * nb, scr, F.lane); continue; }
            r -= 2 * I_IN;
            if (r < 2 * I_SQ) { const int j = r / I_SQ; r %= I_SQ; const int kb = r / 64, nb = r % 64;
                transpose_item(a.gla_w_out + (size_t)j * DM * DM, DM, DM, (bf16*)(ws + WS_WGO) + (size_t)j * DM * DM, 64 * kb, 32 * nb, 32 * nb, scr, F.lane); continue; }
            r -= 2 * I_SQ;
            if (r < 2 * I_SQ) { const int j = r / I_SQ; r %= I_SQ; const int kb = r / 64, nb = r % 64;
                transpose_item(a.fnet_w_out + (size_t)j * DM * DM, DM, DM, (bf16*)(ws + WS_WFO) + (size_t)j * DM * DM, 64 * kb, 32 * nb, 32 * nb, scr, F.lane, 1); continue; }
            r -= 2 * I_SQ;
            if (r < DEPTH * I_GU) { const int j = r / I_GU; r %= I_GU; const int nblk = 2 * DFF / 32, kb = r / nblk, nb = r % nblk, n0 = 32 * nb;
                const int jj = n0 < DFF ? n0 : n0 - DFF; const int drow = (jj >> 7) * 256 + (n0 < DFF ? 0 : 128) + (jj & 127);
                transpose_item(a.ffn_w_gu + (size_t)j * DM * 2 * DFF, DM, 2 * DFF, (bf16*)(ws + WS_WGU) + (size_t)j * 2 * DFF * DM, 64 * kb, n0, drow, scr, F.lane); continue; }
            r -= DEPTH * I_GU;
            { const int j = r / I_DN; r %= I_DN; const int kb = r / 64, nb = r % 64;
                transpose_item(a.ffn_w_down + (size_t)j * DFF * DM, DFF, DM, (bf16*)(ws + WS_WDN) + (size_t)j * DM * DFF, 64 * kb, 32 * nb, 32 * nb, scr, F.lane); }
        }
    }
}

DI void norm_load_x(f32x4 (&v)[8], const void* xlat, const void* xctx, int xin_bf16, int R, int co) {
    if (xin_bf16) { const bf16* xr = R < NLAT ? (const bf16*)xlat + (size_t)R * DM : (const bf16*)xctx + (size_t)(R - NLAT) * DM;
        v2u t[8];
#pragma unroll
        for (int j = 0; j < 8; ++j) t[j] = *(const GAS v2u*)(xr + j * 256 + co);
#pragma unroll
        for (int j = 0; j < 8; ++j) v[j] = (f32x4){bflo(t[j].x), bfhi(t[j].x), bflo(t[j].y), bfhi(t[j].y)}; }
    else { const float* xr = R < NLAT ? (const float*)xlat + (size_t)R * DM : (const float*)xctx + (size_t)(R - NLAT) * DM;
#pragma unroll
        for (int j = 0; j < 8; ++j) v[j] = *(const GAS f32x4*)(xr + j * 256 + co); }
}
DI void phase_norm(const Frame& F0, int nrows, const void* xlat, const void* xctx, int xin_bf16, const bf16* Y, const float* gainY, const float* gate  ,
                   void* Xout_lat, void* Xout_ctx, int xout_bf16, bf16* Hout, const float* gainH, const float* shift, const float* scale) {
    const Frame F = launder(F0);
    const int gw = F.vcu * NWAVES + F.wave, NGW = F.G * NWAVES;
    const int co = F.lane * 4;
    const int nfull = nrows / NGW, xr = F.wave * F.G + F.vcu, nit = nfull + (xr < nrows - nfull * NGW ? 1 : 0);
#define NORM_ROW(i) ((i) < nfull ? gw + (i) * NGW : nfull * NGW + xr)
    f32x4 v[8]; v2u yb[8];
    if (nit > 0) { const int R0 = NORM_ROW(0); norm_load_x(v, xlat, xctx, xin_bf16, R0, co);
        if (Y) {
#pragma unroll
            for (int j = 0; j < 8; ++j) yb[j] = __builtin_nontemporal_load((const GAS v2u*)(Y + (size_t)R0 * DM + j * 256 + co)); } }
    for (int it = 0; it < nit; ++it) {
        const int R = NORM_ROW(it); const int mb = row_mb(R), Rn = NORM_ROW(it + 1);
        f32x4 vn[8]; v2u ybn[8];
        if (it + 1 < nit) { norm_load_x(vn, xlat, xctx, xin_bf16, Rn, co);
            if (Y) {
#pragma unroll
                for (int j = 0; j < 8; ++j) ybn[j] = __builtin_nontemporal_load((const GAS v2u*)(Y + (size_t)Rn * DM + j * 256 + co)); } }
        if (Y) {
            f32x4 gt[8];
#pragma unroll
            for (int j = 0; j < 8; ++j) gt[j] = *(const GAS f32x4*)(gate + (size_t)mb * NADA + j * 256 + co);
            f32x4 y[8]; float ss = 0.f;
#pragma unroll
            for (int j = 0; j < 8; ++j) { y[j] = (f32x4){bflo(yb[j].x), bfhi(yb[j].x), bflo(yb[j].y), bfhi(yb[j].y)};
                ss += (y[j].x * y[j].x + y[j].y * y[j].y) + (y[j].z * y[j].z + y[j].w * y[j].w); }
            const float rs = __builtin_amdgcn_rsqf(wave_sum(ss) * (1.0f / DM) + EPS);
#pragma unroll
            for (int j = 0; j < 8; ++j) v[j] = v[j] + gt[j] * (y[j] * rs);
        }
        f32x4 sh[8], sc[8];
        if (Hout) {
#pragma unroll
            for (int j = 0; j < 8; ++j) { sh[j] = *(const GAS f32x4*)(shift + (size_t)mb * NADA + j * 256 + co); sc[j] = *(const GAS f32x4*)(scale + (size_t)mb * NADA + j * 256 + co); }
        }
        if (Xout_lat) {
            if (xout_bf16) { bf16* xo = R < NLAT ? (bf16*)Xout_lat + (size_t)R * DM : (bf16*)Xout_ctx + (size_t)(R - NLAT) * DM;
#pragma unroll
                for (int j = 0; j < 8; ++j) { v2u o; o.x = pk2(v[j].x, v[j].y); o.y = pk2(v[j].z, v[j].w); *(GAS v2u*)(xo + j * 256 + co) = o; } }
            else { float* xo = R < NLAT ? (float*)Xout_lat + (size_t)R * DM : (float*)Xout_ctx + (size_t)(R - NLAT) * DM;
#pragma unroll
                for (int j = 0; j < 8; ++j) *(GAS f32x4*)(xo + j * 256 + co) = v[j]; } }
        if (Hout) {
            float ss = 0.f;
#pragma unroll
            for (int j = 0; j < 8; ++j) ss += (v[j].x * v[j].x + v[j].y * v[j].y) + (v[j].z * v[j].z + v[j].w * v[j].w);
            const float rs = __builtin_amdgcn_rsqf(wave_sum(ss) * (1.0f / DM) + EPS);
            v2u o[8];
#pragma unroll
            for (int j = 0; j < 8; ++j) { const f32x4 h = (v[j] * rs) * sc[j] + sh[j]; o[j].x = pk2(h.x, h.y); o[j].y = pk2(h.z, h.w); }
#pragma unroll
            for (int j = 0; j < 8; ++j) *(GAS v2u*)(Hout + (size_t)R * DM + j * 256 + co) = o[j];
        }
#pragma unroll
        for (int j = 0; j < 8; ++j) { v[j] = vn[j]; yb[j] = ybn[j]; }
    }
#undef NORM_ROW
}

DI int chunk_row(int b, int ci, int c, int colmajor) {
    if (ci < 4) return NLAT + b * CTXL + ci * 64 + c;
    const int n = ci - 4; const int tok = colmajor ? (c * 64 + n) : (n * 64 + c);
    return b * SEQ + tok;
}
DI float log_sigmoid_f(float x) { return fminf(x, 0.f) - log1pf(__expf(-fabsf(x))); }

DI void phase_lr(const Frame& F0, const Args& a, int jl) {
    const Frame F = launder(F0);
    unsigned char* ws = launder_ptr(a.ws); const bf16* Hb = (const bf16*)(ws + WS_H); const bf16* Wl = (const bf16*)(ws + WS_WIN) + ((size_t)jl * GIN_PAD + 6144) * DM; float* LR = (float*)(ws + WS_LR);
    LAS f32x4* red = (LAS f32x4*)F.lds;
    const int l15 = F.lane & 15, l4 = F.lane >> 4;
    for (int unit = (int)blockIdx.x; unit < MROWS / 64; unit += F.G) {
        const int r0 = unit * 64; f32x4 acc[4][2];
#pragma unroll
        for (int x = 0; x < 4; ++x)
#pragma unroll
            for (int y = 0; y < 2; ++y) acc[x][y] = (f32x4){0.f, 0.f, 0.f, 0.f};
#pragma unroll
        for (int ks = 0; ks < 8; ++ks) { const int k = F.wave * 256 + ks * 32 + 8 * l4;
            const bf16x8 b0 = ld_frag_g(Wl + (size_t)l15 * DM + k), b1 = ld_frag_g(Wl + (size_t)(16 + l15) * DM + k);
#pragma unroll
            for (int x = 0; x < 4; ++x) { const bf16x8 af = ld_frag_g(Hb + (size_t)(r0 + x * 16 + l15) * DM + k); acc[x][0] = mfma16(af, b0, acc[x][0]); acc[x][1] = mfma16(af, b1, acc[x][1]); } }
#pragma unroll
        for (int x = 0; x < 4; ++x)
#pragma unroll
            for (int y = 0; y < 2; ++y) red[(F.wave * 8 + x * 2 + y) * 64 + F.lane] = acc[x][y];
        __syncthreads();
        { const int t = F.wave; f32x4 s = red[t * 64 + F.lane];
#pragma unroll
            for (int w = 1; w < 8; ++w) s += red[(w * 8 + t) * 64 + F.lane];
            const int x = t >> 1, y = t & 1;
#pragma unroll
            for (int r = 0; r < 4; ++r) LR[(size_t)(r0 + x * 16 + 4 * l4 + r) * 32 + y * 16 + l15] = s[r]; }
        __syncthreads();
    }
}

DI int cp_swz(int row, int k) { return row * 512 + ((((k >> 3) ^ (row & 15)) << 4) | ((k & 7) << 1)); }
DI void phase_chunk_prep(const Frame& F0, const Args& a, int jl, int colmajor) {
    const Frame Fo = launder(F0);
    for (int unit = (int)blockIdx.x; unit < NCG * NH; unit += Fo.G) {
    const Frame F = launder(Fo);
    unsigned char* ws = launder_ptr(a.ws);
    const bf16* Qb = (const bf16*)(ws + WS_Q); const bf16* Kb = (const bf16*)(ws + WS_K); const bf16* Vb = (const bf16*)(ws + WS_V); const float* LR = (const float*)(ws + WS_LR);
    bf16* QD = (bf16*)(ws + WS_QD); bf16* KET = (bf16*)(ws + WS_KET); bf16* VT = (bf16*)(ws + WS_VT); bf16* AM = (bf16*)(ws + WS_AM); float* DEC = (float*)(ws + WS_DEC);
    LAS float* lf = (LAS float*)(F.lds + 136192);
    const int dir = F.tid >> 8, k = F.tid & 255, ww = F.wave & 3;
    LAS unsigned char* qd_l = F.lds + dir * 32768;
    LAS unsigned char* ki_l = F.lds + 65536 + dir * 32768;
    {
        const int cg = unit >> 2, h = unit & 3, b = cg / NCHUNK, ci = cg % NCHUNK;
#pragma unroll
        for (int i = 0; i < 8; ++i) { const int r = (ww * 8 + i) * 2 + (F.lane >> 5), lc = (F.lane & 31) ^ (r & 15); const int R = chunk_row(b, ci, r, colmajor);
            __builtin_amdgcn_global_load_lds((const unsigned*)(Qb + (size_t)R * KD + h * HK + lc * 8), (LAS unsigned*)(qd_l + (ww * 8 + i) * 1024), 16, 0, 0);
            __builtin_amdgcn_global_load_lds((const unsigned*)(Kb + (size_t)R * KD + h * HK + lc * 8), (LAS unsigned*)(ki_l + (ww * 8 + i) * 1024), 16, 0, 0); }
        { const int c = F.tid >> 3, r4 = (F.tid & 7) * 4; const int R = chunk_row(b, ci, c, colmajor);
          *(LAS f32x4*)(lf + c * 32 + r4) = *(const GAS f32x4*)(LR + (size_t)R * 32 + r4); }
        const float* wg2 = dir ? a.gla_wg2_b : a.gla_wg2_f; const float* bg = dir ? a.gla_bg_b : a.gla_bg_f;
        const float bias = *(const GAS float*)(bg + (size_t)jl * KD + h * HK + k);
        const int hh = F.lane >> 5, li = F.lane & 31;
        bf16x8 Bf[2];
#pragma unroll
        for (int j = 0; j < 2; ++j) { float wv[8];
#pragma unroll
            for (int jj = 0; jj < 8; ++jj) wv[jj] = *(const GAS float*)(wg2 + ((size_t)jl * GR + 8 * hh + jj) * KD + h * HK + (F.wave & 3) * 64 + 32 * j + li);
            const v4u pkw = (v4u){pk2(wv[0], wv[1]), pk2(wv[2], wv[3]), pk2(wv[4], wv[5]), pk2(wv[6], wv[7])}; Bf[j] = __builtin_bit_cast(bf16x8, pkw); }
        VM_WAIT(); __syncthreads();
        float cum[64];
        { typedef float f32x16 __attribute__((ext_vector_type(16)));
          f32x16 z; for (int i = 0; i < 16; ++i) z[i] = 0.f;
#pragma unroll
          for (int t = 0; t < 2; ++t) {
              bf16x8 Af[2];
#pragma unroll
              for (int x = 0; x < 2; ++x) { const LAS f32x4* l = (const LAS f32x4*)(lf + (32 * t + (li ^ (4 * x))) * 32 + dir * 16 + 8 * hh);
                  const f32x4 a0 = l[0], a1 = l[1];
                  const v4u pka = (v4u){pk2(a0.x, a0.y), pk2(a0.z, a0.w), pk2(a1.x, a1.y), pk2(a1.z, a1.w)}; Af[x] = __builtin_bit_cast(bf16x8, pka); }
#pragma unroll
              for (int v = 0; v < 4; ++v) { const int hi_rows = v >> 1, upper = v & 1;
                  const f32x16 P = __builtin_amdgcn_mfma_f32_32x32x16_bf16(Af[hi_rows ^ upper], Bf[upper], z, 0, 0, 0);
#pragma unroll
                  for (int r = 0; r < 16; ++r) { const int c = 32 * t + 8 * (r >> 2) + 4 * hi_rows + (r & 3); cum[c] = upper ? (hh ? P[r] : cum[c]) : P[r]; }
                  __builtin_amdgcn_sched_barrier(0); }
          }
        }
#pragma unroll
        for (int c = 0; c < 64; ++c) { const float s = cum[c] + bias;
            cum[c] = fminf(s, 0.f) * (1.0f / 16.0f) - __builtin_amdgcn_logf(1.0f + __builtin_amdgcn_exp2f(-1.44269504f * fabsf(s))) * (0.69314718f / 16.0f); }
        if (dir == 0) {
#pragma unroll
            for (int c = 1; c < 64; ++c) cum[c] += cum[c - 1];
        } else {
#pragma unroll
            for (int c = 62; c >= 0; --c) cum[c] += cum[c + 1];
        }
        const float last = dir == 0 ? cum[63] : cum[0]; const float elast = __expf(last);
        *(GAS float*)(DEC + (((size_t)dir * NCG + cg) * NH + h) * HK + k) = elast;
        unsigned kep[32];
#pragma unroll
        for (int cb = 0; cb < 64; cb += 16) {
            unsigned short qr[16], kr[16];
#pragma unroll
            for (int u = 0; u < 16; ++u) { const int off = cp_swz(cb + u, k); qr[u] = *(const LAS unsigned short*)(qd_l + off); kr[u] = *(const LAS unsigned short*)(ki_l + off); }
#pragma unroll
            for (int u2 = 0; u2 < 8; ++u2) { float ke2[2];
#pragma unroll
                for (int u = 0; u < 2; ++u) { const int c = cb + 2 * u2 + u; const int off = cp_swz(c, k);
                    const float q = bf2f(qr[2 * u2 + u]), kk = bf2f(kr[2 * u2 + u]);
                    const float ec = __expf(cum[c]); const float qd = q * ec, kinv = kk * __builtin_amdgcn_rcpf(ec); ke2[u] = kinv * elast;
                    const unsigned qk = pk2(qd, kinv);
                    *(GAS unsigned short*)(QD + ((((size_t)dir * NCG + cg) * NH + h) * 64 + c) * HK + k) = (unsigned short)qk;
                    *(LAS unsigned short*)(qd_l + off) = (unsigned short)qk;
                    *(LAS unsigned short*)(ki_l + off) = (unsigned short)(qk >> 16); }
                kep[(cb >> 1) + u2] = pk2(ke2[0], ke2[1]); } }
        { GAS v4u* dst = (GAS v4u*)(KET + ((((size_t)dir * NCG + cg) * NH + h) * HK + k) * 64);
#pragma unroll
          for (int q = 0; q < 8; ++q) dst[q] = (v4u){kep[4 * q], kep[4 * q + 1], kep[4 * q + 2], kep[4 * q + 3]}; }
        __syncthreads();
#pragma unroll
        for (int tt = 0; tt < 4; ++tt) { const int t = 4 * F.wave + tt, d = t >> 4, jt = (t >> 2) & 3, it = t & 3; f32x4 acc = {0.f, 0.f, 0.f, 0.f};
            const int rj = jt * 16 + (F.lane & 15), ri = it * 16 + (F.lane & 15);
            const LAS unsigned char* kb = F.lds + 65536 + d * 32768 + rj * 512; const LAS unsigned char* qb = F.lds + d * 32768 + ri * 512;
#pragma unroll
            for (int kk = 0; kk < 8; ++kk) { const int ch = kk * 4 + (F.lane >> 4);
                acc = mfma16(ld_frag_l(kb + ((ch ^ (rj & 15)) << 4)), ld_frag_l(qb + ((ch ^ (ri & 15)) << 4)), acc); }
            const int i = ri, j0 = jt * 16 + 4 * (F.lane >> 4); float o[4];
#pragma unroll
            for (int r = 0; r < 4; ++r) { const int j = j0 + r; const bool keep = d == 0 ? (j <= i) : (j >= i); o[r] = keep ? acc[r] : 0.f; }
            v2u pkd; pkd.x = pk2(o[0], o[1]); pkd.y = pk2(o[2], o[3]);
            *(GAS v2u*)(AM + ((((size_t)d * NCG + cg) * NH + h) * 64 + i) * 64 + j0) = pkd; }
        __syncthreads();
    }
    }
}

constexpr int SC_QD = 0, SC_KE = 33792, SC_VT = 70656, SC_AM = 79872, SC_ST = 89088;
struct ScanFr { v4u q[4], ke[4], vt, am, dq; };
constexpr int SC_DEC = 122880;
constexpr int SC_ST1 = 123904;
DI int scan_ci(int s, int dir) { return dir == 0 ? s : (s < 4 ? 3 - s : 4 + (63 - (s - 4))); }
struct ScanCtx { const bf16 *QD, *KET, *V, *AM; const float* DEC; bf16* O; LAS unsigned char* L; int b, h, dir, sl, tid, w, l15, l4, lane, colmajor; unsigned oq0, oq1, oq2, oq3, oqc0, oqc1, oqc2, oqc3, oo0, oo1, ooc0, ooc1, ov, ovc; };
DI int scan_rowbase(const ScanCtx& c, int ci) { return ci < 4 ? NLAT + c.b * CTXL + ci * 64 : (c.colmajor ? c.b * SEQ + (ci - 4) : c.b * SEQ + (ci - 4) * 64); }
DI void scan_load(ScanFr& f, int s, const ScanCtx& c) {
    s = s < NCHUNK ? s : NCHUNK - 1;
    const int ci = scan_ci(s, c.dir), cg = c.b * NCHUNK + ci; const bool lin = ci < 4 || !c.colmajor;
    const char* qb = (const char*)c.QD + (((size_t)c.dir * NCG + cg) * NH + c.h) * 64 * HK * 2 + c.tid * 16;
#pragma unroll
    for (int i = 0; i < 4; ++i) f.q[i] = *(const GAS v4u*)(qb + i * 8192);
    const char* kb = (const char*)c.KET + (((size_t)c.dir * NCG + cg) * NH + c.h) * HK * 64 * 2 + c.tid * 16;
#pragma unroll
    for (int i = 0; i < 4; ++i) f.ke[i] = *(const GAS v4u*)(kb + i * 8192);
    f.vt = *(const GAS v4u*)((const char*)c.V + (size_t)scan_rowbase(c, ci) * VD * 2 + (lin ? c.ov : c.ovc));
    f.am = *(const GAS v4u*)((const char*)c.AM + (((size_t)c.dir * NCG + cg) * NH + c.h) * 64 * 64 * 2 + c.tid * 16);
    f.dq = *(const GAS v4u*)((const char*)c.DEC + (((size_t)c.dir * NCG + cg) * NH + c.h) * HK * 4 + (c.tid & 63) * 16);
}
template <int PAR> DI void scan_step64(ScanFr& f, f32x4 (&S)[2][4], int s, const ScanCtx& c) {
    LAS unsigned char* L = c.L; const int tid = c.tid, w = c.w, l15 = c.l15, l4 = c.l4;
    const int ci = scan_ci(s, c.dir);
#pragma unroll
    for (int i = 0; i < 4; ++i) { const int p = tid + 512 * i; *(LAS v4u*)(L + SC_QD + (p >> 5) * 528 + (p & 31) * 16) = f.q[i]; *(LAS v4u*)(L + SC_KE + (p >> 3) * 144 + (p & 7) * 16) = f.ke[i]; }
    *(LAS v4u*)(L + SC_VT + (tid >> 3) * 144 + (tid & 7) * 16) = f.vt; *(LAS v4u*)(L + SC_AM + (tid >> 3) * 144 + (tid & 7) * 16) = f.am;
    if (tid < 64) *(LAS v4u*)(L + SC_DEC + tid * 16) = f.dq;
    __syncthreads();
    const f32x4 dec0 = *(const LAS f32x4*)(L + SC_DEC + ((2 * w) * 16 + 4 * l4) * 4), dec1 = *(const LAS f32x4*)(L + SC_DEC + ((2 * w + 1) * 16 + 4 * l4) * 4);
    scan_load(f, s + 2, c);
#define SC_VFR(e0, c0) __builtin_shufflevector(vtr(L + SC_VT + ((c0) + 8 * l4 + (l15 >> 2)) * 144 + ((e0) + 4 * (l15 & 3)) * 2), vtr(L + SC_VT + ((c0) + 8 * l4 + (l15 >> 2) + 4) * 144 + ((e0) + 4 * (l15 & 3)) * 2), 0, 1, 2, 3, 4, 5, 6, 7)
    bf16x8 kf[2][2];
#pragma unroll
    for (int x = 0; x < 2; ++x)
#pragma unroll
        for (int cc = 0; cc < 2; ++cc) kf[x][cc] = ld_frag_l(L + SC_KE + ((2 * w + x) * 16 + l15) * 144 + (cc * 32 + 8 * l4) * 2);
    const int et = w & 3, ct0 = 2 * (w >> 2);
    {
        bf16x8 va[2], vb[2];
#pragma unroll
        for (int cc = 0; cc < 2; ++cc) va[cc] = SC_VFR(0 * 16, cc * 32);
#pragma unroll
        for (int y = 0; y < 4; y += 2) {
#pragma unroll
            for (int cc = 0; cc < 2; ++cc) vb[cc] = SC_VFR((y + 1) * 16, cc * 32);
#pragma unroll
            for (int x = 0; x < 2; ++x) { f32x4 acc = S[x][y] * (x ? dec1 : dec0);
#pragma unroll
                for (int cc = 0; cc < 2; ++cc) acc = mfma16(kf[x][cc], va[cc], acc);
                S[x][y] = acc; }
            if (y + 2 < 4) {
#pragma unroll
                for (int cc = 0; cc < 2; ++cc) va[cc] = SC_VFR((y + 2) * 16, cc * 32); }
#pragma unroll
            for (int x = 0; x < 2; ++x) { f32x4 acc = S[x][y + 1] * (x ? dec1 : dec0);
#pragma unroll
                for (int cc = 0; cc < 2; ++cc) acc = mfma16(kf[x][cc], vb[cc], acc);
                S[x][y + 1] = acc; }
        }
    }
#pragma unroll
    for (int x = 0; x < 2; ++x)
#pragma unroll
        for (int y = 0; y < 4; ++y) { const int kk = (2 * w + x) * 16 + 4 * l4, e = y * 16 + l15; v2u p; p.x = pk2(S[x][y][0], S[x][y][1]); p.y = pk2(S[x][y][2], S[x][y][3]);
            *(LAS v2u*)(L + (PAR ? SC_ST : SC_ST1) + e * 528 + kk * 2) = p; }
    const bool lin = ci < 4 || !c.colmajor;
    char* ob = (char*)c.O + ((size_t)c.dir * MROWS + scan_rowbase(c, ci)) * VD * 2;
    f32x4 o0 = {0.f, 0.f, 0.f, 0.f}, o1 = o0;
    bf16x8 A0, B00, B01, A1, B10, B11;
#define SC_OFR(i, A, Ba, Bb) do { if ((i) < 2) { A = SC_VFR(et * 16, (i) * 32); Ba = ld_frag_l(L + SC_AM + (ct0 * 16 + l15) * 144 + ((i) * 32 + 8 * l4) * 2); Bb = ld_frag_l(L + SC_AM + ((ct0 + 1) * 16 + l15) * 144 + ((i) * 32 + 8 * l4) * 2); } \
        else { A = ld_frag_l(L + (PAR ? SC_ST1 : SC_ST) + (et * 16 + l15) * 528 + (((i) - 2) * 32 + 8 * l4) * 2); Ba = ld_frag_l(L + SC_QD + (ct0 * 16 + l15) * 528 + (((i) - 2) * 32 + 8 * l4) * 2); Bb = ld_frag_l(L + SC_QD + ((ct0 + 1) * 16 + l15) * 528 + (((i) - 2) * 32 + 8 * l4) * 2); } } while (0)
    SC_OFR(0, A0, B00, B01);
#pragma unroll
    for (int i = 0; i < 10; i += 2) {
        SC_OFR(i + 1, A1, B10, B11);
        o0 = mfma16(A0, B00, o0); o1 = mfma16(A0, B01, o1);
        if (i + 2 < 10) SC_OFR(i + 2, A0, B00, B01);
        o0 = mfma16(A1, B10, o0); o1 = mfma16(A1, B11, o1);
    }
#undef SC_OFR
#undef SC_VFR
    { v2u p; p.x = pk2(o0[0], o0[1]); p.y = pk2(o0[2], o0[3]); *(GAS v2u*)(ob + (lin ? c.oo0 : c.ooc0)) = p;
      v2u q; q.x = pk2(o1[0], o1[1]); q.y = pk2(o1[2], o1[3]); *(GAS v2u*)(ob + (lin ? c.oo1 : c.ooc1)) = q; }
    __syncthreads();
}
DI void phase_scan(const Frame& F0, const Args& a, int colmajor) {
    const Frame F = launder(F0);
    unsigned char* ws = launder_ptr(a.ws);
    ScanCtx c; c.QD = (const bf16*)(ws + WS_QD); c.KET = (const bf16*)(ws + WS_KET); c.V = (const bf16*)(ws + WS_V); c.AM = (const bf16*)(ws + WS_AM); c.DEC = (const float*)(ws + WS_DEC);
    c.O = (bf16*)(ws + WS_O); c.L = F.lds; c.tid = F.tid; c.w = F.wave; c.lane = F.lane; c.l15 = F.lane & 15; c.l4 = F.lane >> 4; c.colmajor = colmajor;
    for (int it = F.vcu; it < 256; it += F.G) {
        if ((it & 31) >= 16) continue;
        const int item = (it >> 5) * 16 + (it & 15), bhd = item >> 3;
        c.sl = item & 7; c.b = bhd >> 3; c.h = (bhd >> 1) & 3; c.dir = bhd & 1;
#define SC_OQ(i, lin_) (unsigned)(((((c.tid + 512 * (i)) >> 5) * ((lin_) ? 1 : 64)) * KD + c.h * HK + ((c.tid + 512 * (i)) & 31) * 8) * 2)
        c.oq0 = SC_OQ(0, 1); c.oq1 = SC_OQ(1, 1); c.oq2 = SC_OQ(2, 1); c.oq3 = SC_OQ(3, 1); c.oqc0 = SC_OQ(0, 0); c.oqc1 = SC_OQ(1, 0); c.oqc2 = SC_OQ(2, 0); c.oqc3 = SC_OQ(3, 0);
#undef SC_OQ
#define SC_OO(t, lin_) (unsigned)(((((2 * (c.w >> 2) + (t)) * 16 + c.l15) * ((lin_) ? 1 : 64)) * VD + c.h * HV + c.sl * 64 + (c.w & 3) * 16 + 4 * c.l4) * 2)
        c.oo0 = SC_OO(0, 1); c.oo1 = SC_OO(1, 1); c.ooc0 = SC_OO(0, 0); c.ooc1 = SC_OO(1, 0);
        c.ov = (unsigned)(((c.tid >> 3) * VD + c.h * HV + c.sl * 64 + (c.tid & 7) * 8) * 2); c.ovc = (unsigned)(((c.tid >> 3) * 64 * VD + c.h * HV + c.sl * 64 + (c.tid & 7) * 8) * 2);
#undef SC_OO
        f32x4 S[2][4];
#pragma unroll
        for (int x = 0; x < 2; ++x)
#pragma unroll
            for (int y = 0; y < 4; ++y) S[x][y] = (f32x4){0.f, 0.f, 0.f, 0.f};
        ScanFr fa, fb;
        scan_load(fa, 0, c); scan_load(fb, 1, c);
#pragma unroll
        for (int x = 0; x < 2; ++x)
#pragma unroll
            for (int y = 0; y < 4; ++y) *(LAS v2u*)(c.L + SC_ST + (y * 16 + c.l15) * 528 + ((2 * c.w + x) * 16 + 4 * c.l4) * 2) = (v2u){0u, 0u};
        for (int s = 0; s < NCHUNK; s += 2) { scan_step64<0>(fa, S, s, c); scan_step64<1>(fb, S, s + 1, c); }
    }
}

DI void phase_gla_post(const Frame& F0, const Args& a, int jl, int nrows) {
    const Frame F = launder(F0);
    unsigned char* ws = launder_ptr(a.ws);
    const bf16* O = (const bf16*)(ws + WS_O); const bf16* Rb = (const bf16*)(ws + WS_R); bf16* U = (bf16*)(ws + WS_H);
    const int gw = F.vcu * NWAVES + F.wave, NGW = F.G * NWAVES;
    const f32x4 g0 = *(const GAS f32x4*)(a.gla_head_gain + (size_t)jl * HV + F.lane * 8), g1 = *(const GAS f32x4*)(a.gla_head_gain + (size_t)jl * HV + F.lane * 8 + 4);
    v4u of[4], ob[4], rr[4];
    const int nfull = nrows / NGW, xr = F.wave * F.G + F.vcu, nit = nfull + (xr < nrows - nfull * NGW ? 1 : 0);
#define POST_ROW(i) ((i) < nfull ? gw + (i) * NGW : nfull * NGW + xr)
    if (nit > 0) { const int R0 = POST_ROW(0);
#pragma unroll
        for (int j = 0; j < 4; ++j) { const size_t off = (size_t)R0 * VD + j * HV + F.lane * 8;
            of[j] = __builtin_nontemporal_load((const GAS v4u*)(O + off)); ob[j] = __builtin_nontemporal_load((const GAS v4u*)(O + (size_t)MROWS * VD + off)); rr[j] = __builtin_nontemporal_load((const GAS v4u*)(Rb + off)); } }
    for (int it = 0; it < nit; ++it) { const int R = POST_ROW(it);
        v4u ofn[4], obn[4], rrn[4]; const int Rn = POST_ROW(it + 1);
        if (it + 1 < nit) {
#pragma unroll
            for (int j = 0; j < 4; ++j) { const size_t off = (size_t)Rn * VD + j * HV + F.lane * 8;
                ofn[j] = __builtin_nontemporal_load((const GAS v4u*)(O + off)); obn[j] = __builtin_nontemporal_load((const GAS v4u*)(O + (size_t)MROWS * VD + off)); rrn[j] = __builtin_nontemporal_load((const GAS v4u*)(Rb + off)); } }
        v4u wout[4];
#pragma unroll
        for (int j = 0; j < 4; ++j) {
            float o[8], r[8];
#pragma unroll
            for (int q = 0; q < 4; ++q) { o[2 * q] = bflo(of[j][q]) + bflo(ob[j][q]); o[2 * q + 1] = bfhi(of[j][q]) + bfhi(ob[j][q]); r[2 * q] = bflo(rr[j][q]); r[2 * q + 1] = bfhi(rr[j][q]); }
            float ss = 0.f;
#pragma unroll
            for (int q = 0; q < 8; ++q) ss += o[q] * o[q];
            const float rs = __builtin_amdgcn_rsqf(wave_sum(ss) * (1.0f / HV) + EPS);
            float u[8];
#pragma unroll
            for (int q = 0; q < 8; ++q) { const float g = q < 4 ? g0[q] : g1[q - 4]; u[q] = o[q] * rs * g * silu_f(r[q]); }
            wout[j] = (v4u){pk2(u[0], u[1]), pk2(u[2], u[3]), pk2(u[4], u[5]), pk2(u[6], u[7])};
        }
#pragma unroll
        for (int j = 0; j < 4; ++j) *(GAS v4u*)(U + (size_t)R * VD + j * HV + F.lane * 8) = wout[j];
#pragma unroll
        for (int j = 0; j < 4; ++j) { of[j] = ofn[j]; ob[j] = obn[j]; rr[j] = rrn[j]; }
    }
#undef POST_ROW
}

template <int NK, int NM, class RowIn, class Store>
DI void dft_unit(const Frame& F, const RowIn& rin, const bf16* Mx  , const Store& st) {
    LAS unsigned char* D = F.lds;
    constexpr int PIECES = NK * 8;
    for (int p = F.tid; p < PIECES; p += 512) { const int row = p >> 3, ch = p & 7; *(LAS v4u*)(D + row * 144 + ch * 16) = *(const GAS v4u*)(rin(row) + ch * 8); }
    __syncthreads();
    const int l15 = F.lane & 15, l4 = F.lane >> 4, q = l15 >> 2, pp = l15 & 3;
    constexpr int TPW = NM / 32;
#pragma unroll
    for (int i = 0; i < TPW; ++i) { const int t = F.wave * TPW + i, mt = t >> 2, ct = t & 3; f32x4 acc = {0.f, 0.f, 0.f, 0.f};
#pragma unroll 4
        for (int kk = 0; kk < NK / 32; ++kk) {
            const LAS unsigned char* ad = D + (kk * 32 + 8 * l4 + q) * 144 + (ct * 16 + 4 * pp) * 2;
            const s16x4 lo = vtr(ad), hi = vtr(ad + 4 * 144);
            const bf16x8 af = __builtin_shufflevector(lo, hi, 0, 1, 2, 3, 4, 5, 6, 7);
            const bf16x8 bfr = ld_frag_g(Mx + (size_t)(mt * 16 + l15) * NK + kk * 32 + 8 * l4);
            acc = mfma16(af, bfr, acc); }
        st(mt * 16 + l15, ct * 16 + 4 * l4, acc); }
    __syncthreads();
}
struct RowInS1 { const bf16* base; DI const bf16* operator()(int row) const { const int pi = row >> 6, n1 = row & 63; return base + (size_t)(64 * n1) * 4096 + pi * 512; } };
struct StoreS1 { bf16* base; DI void operator()(int m, int ch, const f32x4& v) const { const int po = m >> 6, k1 = m & 63; v2u p; p.x = pk2(v[0], v[1]); p.y = pk2(v[2], v[3]);
    *(GAS v2u*)(base + (size_t)(k1 * 64) * 4096 + po * 512 + ch) = p; } };
struct RowInS2 { const bf16* base; DI const bf16* operator()(int row) const { const int pi = row >> 6, n2 = row & 63; return base + (size_t)n2 * 4096 + pi * 512; } };
struct StoreS2 { bf16* base; float sc; DI void operator()(int m, int ch, const f32x4& v) const { v2u p; p.x = pk2(v[0] * sc, v[1] * sc); p.y = pk2(v[2] * sc, v[3] * sc);
    *(GAS v2u*)(base + (size_t)(64 * m) * DM + ch) = p; } };
struct RowInC { const bf16* base; DI const bf16* operator()(int row) const { const int pi = row >> 8, n = row & 255; return base + (size_t)n * 4096 + pi * 512; } };
struct StoreC { bf16* base; float sc; DI void operator()(int m, int ch, const f32x4& v) const { v2u p; p.x = pk2(v[0] * sc, v[1] * sc); p.y = pk2(v[2] * sc, v[3] * sc);
    *(GAS v2u*)(base + (size_t)m * DM + ch) = p; } };

template <int NM, class Spec, int NU = 16>
DI void dft_pipe16(const Frame& F, const Spec& spec, int u0, const bf16* Mx) {
    constexpr int NK = 128, TPW = NM / 32, TILE = NK * 144;
    const int l15 = F.lane & 15, l4 = F.lane >> 4, q = l15 >> 2, pp = l15 & 3;
    const int mt = (F.wave * TPW) >> 2;
    bf16x8 mx[4];
#pragma unroll
    for (int kk = 0; kk < 4; ++kk) mx[kk] = ld_frag_g(Mx + (size_t)(mt * 16 + l15) * NK + kk * 32 + 8 * l4);
    v4u pre[2];
    { const auto ri = spec.rin(u0);
#pragma unroll
      for (int i = 0; i < 2; ++i) { const int p = F.tid + 512 * i; pre[i] = *(const GAS v4u*)(ri(p >> 3) + (p & 7) * 8); } }
#pragma unroll
    for (int i = 0; i < 2; ++i) { const int p = F.tid + 512 * i; *(LAS v4u*)(F.lds + (p >> 3) * 144 + (p & 7) * 16) = pre[i]; }
    __syncthreads();
    for (int k = 0; k < NU; ++k) {
        LAS unsigned char* D = F.lds + (k & 1) * TILE;
        if (k + 1 < NU) { const auto ri = spec.rin(u0 + k + 1);
#pragma unroll
            for (int i = 0; i < 2; ++i) { const int p = F.tid + 512 * i; pre[i] = *(const GAS v4u*)(ri(p >> 3) + (p & 7) * 8); } }
        const auto st = spec.sto(u0 + k);
#pragma unroll
        for (int i = 0; i < TPW; ++i) { const int ct = (F.wave * TPW + i) & 3; f32x4 acc = {0.f, 0.f, 0.f, 0.f};
#pragma unroll
            for (int kk = 0; kk < 4; ++kk) {
                const LAS unsigned char* ad = D + (kk * 32 + 8 * l4 + q) * 144 + (ct * 16 + 4 * pp) * 2;
                const s16x4 lo = vtr(ad), hi = vtr(ad + 4 * 144);
                acc = mfma16(__builtin_shufflevector(lo, hi, 0, 1, 2, 3, 4, 5, 6, 7), mx[kk], acc); }
            st(mt * 16 + l15, ct * 16 + 4 * l4, acc); }
        if (k + 1 < NU) { LAS unsigned char* Dn = F.lds + ((k + 1) & 1) * TILE;
#pragma unroll
            for (int i = 0; i < 2; ++i) { const int p = F.tid + 512 * i; *(LAS v4u*)(Dn + (p >> 3) * 144 + (p & 7) * 16) = pre[i]; } }
        __syncthreads();
    }
}
struct StoreS2m { bf16* H; int b, k1, g, mb; float sc;
    DI void operator()(int m, int ch, const f32x4& v) const { const int tp = 64 * m + k1; bf16* row = H + (size_t)(b * SEQ + tp) * DM + g * 512;
        if (mb == 4) { if (ch == 0) *(GAS unsigned short*)(row + 256) = (unsigned short)pk2(v[0] * sc, 0.f); return; }
        v2u p; p.x = pk2(v[0] * sc, v[1] * sc); p.y = pk2(v[2] * sc, v[3] * sc);
        *(GAS v2u*)(row + mb * 64 + ch) = p;
        bf16* mrow = H + (size_t)(b * SEQ + ((SEQ - tp) & (SEQ - 1))) * DM + g * 512 + 256 + mb * 64 + ch;
        if (mb == 0 && ch == 0) { *(GAS unsigned short*)(mrow + 1) = (unsigned short)(p.x >> 16); *(GAS unsigned*)(mrow + 2) = p.y; }
        else *(GAS v2u*)(mrow) = p; } };
struct SpecS2 { const bf16* T; bf16* Hb;
    DI RowInS2 rin(int u) const { const int b = u / 1280, r = u % 1280, k1 = r / 20, g = (r % 20) / 5, mb = r % 5; return RowInS2{T + (size_t)(b * SEQ + k1 * 64) * 4096 + g * 1024 + mb * 64}; }
    DI StoreS2m sto(int u) const { const int b = u / 1280, r = u % 1280, k1 = r / 20, g = (r % 20) / 5, mb = r % 5; return StoreS2m{Hb, b, k1, g, mb, 0.000690533966f  }; } };

DI void s1_pipe8(const Frame& F, const bf16* UC, bf16* T, int u0, const bf16* Mx  ) {
    constexpr int TILE = 128 * 144;
    const int l15 = F.lane & 15, l4 = F.lane >> 4, q = l15 >> 2, pp = l15 & 3;
    const int kt = F.wave & 3, cp = F.wave >> 2;
    bf16x8 mcs[2], msn[2];
#pragma unroll
    for (int kk = 0; kk < 2; ++kk) { mcs[kk] = ld_frag_g(Mx + (size_t)(kt * 16 + l15) * 64 + kk * 32 + 8 * l4); msn[kk] = ld_frag_g(Mx + (size_t)(64 + kt * 16 + l15) * 64 + kk * 32 + 8 * l4); }
#define S1_ROW(u, row) (UC + ((size_t)(((u) >> 10) * SEQ + (((u) >> 4) & 63)) + (size_t)64 * ((row) & 63)) * 2048 + (((u) >> 2) & 3) * 512 + ((row) >> 6) * 256 + ((u) & 3) * 64)
    v4u pre[2];
#pragma unroll
    for (int i = 0; i < 2; ++i) { const int p = F.tid + 512 * i; pre[i] = *(const GAS v4u*)(S1_ROW(u0, p >> 3) + (p & 7) * 8); }
#pragma unroll
    for (int i = 0; i < 2; ++i) { const int p = F.tid + 512 * i; *(LAS v4u*)(F.lds + (p >> 3) * 144 + (p & 7) * 16) = pre[i]; }
    __syncthreads();
    for (int k = 0; k < 8; ++k) {
        LAS unsigned char* D = F.lds + (k & 1) * TILE;
        const int u = u0 + k;
        if (k + 1 < 8) {
#pragma unroll
            for (int i = 0; i < 2; ++i) { const int p = F.tid + 512 * i; pre[i] = *(const GAS v4u*)(S1_ROW(u + 1, p >> 3) + (p & 7) * 8); } }
        const int b = u >> 10, n2 = (u >> 4) & 63, g = (u >> 2) & 3, mb = u & 3;
        bf16* Tb = T + ((size_t)(b * SEQ + n2) + (size_t)(kt * 16 + l15) * 64) * 4096 + g * 1024 + mb * 64;
#pragma unroll
        for (int i = 0; i < 2; ++i) { const int ct = 2 * cp + i; f32x4 cA = {0.f, 0.f, 0.f, 0.f}, sA = cA, cB = cA, sB = cA;
#pragma unroll
            for (int kk = 0; kk < 2; ++kk) {
                const LAS unsigned char* ad = D + (kk * 32 + 8 * l4 + q) * 144 + (ct * 16 + 4 * pp) * 2;
                const s16x4 lo = vtr(ad), hi = vtr(ad + 4 * 144); const bf16x8 af = __builtin_shufflevector(lo, hi, 0, 1, 2, 3, 4, 5, 6, 7);
                cA = mfma16(af, mcs[kk], cA); sA = mfma16(af, msn[kk], sA);
                const LAS unsigned char* bd = ad + 64 * 144;
                const s16x4 lo2 = vtr(bd), hi2 = vtr(bd + 4 * 144); const bf16x8 bf_ = __builtin_shufflevector(lo2, hi2, 0, 1, 2, 3, 4, 5, 6, 7);
                cB = mfma16(bf_, mcs[kk], cB); sB = mfma16(bf_, msn[kk], sB); }
            f32x4 sre = cA + sB, sim = cB - sA;
            if (mb == 0 && ct == 0 && l4 == 0) { sre[0] = cA[0]; sim[0] = -sA[0];
                *(GAS unsigned short*)(Tb + 256) = (unsigned short)pk2(cB[0], 0.f); *(GAS unsigned short*)(Tb + 512 + 256) = (unsigned short)pk2(-sB[0], 0.f); }
            const int ch = ct * 16 + 4 * l4; v2u p;
            p.x = pk2(sre[0], sre[1]); p.y = pk2(sre[2], sre[3]); *(GAS v2u*)(Tb + ch) = p;
            p.x = pk2(sim[0], sim[1]); p.y = pk2(sim[2], sim[3]); *(GAS v2u*)(Tb + 512 + ch) = p; }
        if (k + 1 < 8) { LAS unsigned char* Dn = F.lds + ((k + 1) & 1) * TILE;
#pragma unroll
            for (int i = 0; i < 2; ++i) { const int p = F.tid + 512 * i; *(LAS v4u*)(Dn + (p >> 3) * 144 + (p & 7) * 16) = pre[i]; } }
        __syncthreads();
    }
#undef S1_ROW
}
DI void ctx_unit(const Frame& F, const bf16* UC, bf16* Hb, int unit, const bf16* MC  ) {
    const int kq = unit & 3, u5 = unit >> 2, b = u5 >> 4, g = (u5 >> 2) & 3, mb = u5 & 3;
    LAS unsigned char* D = F.lds;
    const bf16* src = UC + (size_t)(NLAT + b * CTXL) * 2048 + g * 512 + mb * 64;
    for (int p = F.tid; p < 512 * 8; p += 512) { const int row = p >> 3, c8 = p & 7; *(LAS v4u*)(D + row * 144 + c8 * 16) = *(const GAS v4u*)(src + (size_t)(row & 255) * 2048 + (row >> 8) * 256 + c8 * 8); }
    __syncthreads();
    const int l15 = F.lane & 15, l4 = F.lane >> 4, q = l15 >> 2, pp = l15 & 3;
    const bf16* Mq = MC + (size_t)kq * 64 * 512; const float sc = 0.00276213586f  ;
#pragma unroll
    for (int i = 0; i < 2; ++i) { const int t = F.wave * 2 + i, mt = t >> 2, ct = t & 3; f32x4 aA = {0.f, 0.f, 0.f, 0.f}, aB = aA, aBc = aA;
        const bool z0 = (mb == 0 && ct == 0);
#pragma unroll 4
        for (int kk = 0; kk < 8; ++kk) {
            const LAS unsigned char* ad = D + (kk * 32 + 8 * l4 + q) * 144 + (ct * 16 + 4 * pp) * 2;
            const s16x4 lo = vtr(ad), hi = vtr(ad + 4 * 144); const bf16x8 af = __builtin_shufflevector(lo, hi, 0, 1, 2, 3, 4, 5, 6, 7);
            const bf16x8 mcf = ld_frag_g(Mq + (size_t)(mt * 16 + l15) * 512 + kk * 32 + 8 * l4);
            aA = mfma16(af, mcf, aA);
            const LAS unsigned char* bd = ad + 256 * 144;
            const s16x4 lo2 = vtr(bd), hi2 = vtr(bd + 4 * 144); const bf16x8 bf_ = __builtin_shufflevector(lo2, hi2, 0, 1, 2, 3, 4, 5, 6, 7);
            aB = mfma16(bf_, ld_frag_g(Mq + (size_t)(mt * 16 + l15) * 512 + 256 + kk * 32 + 8 * l4), aB);
            if (z0) aBc = mfma16(bf_, mcf, aBc); }
        f32x4 sm = aA + aB; const int kp = kq * 64 + mt * 16 + l15, pos = mb * 64 + ct * 16 + 4 * l4;
        const bool sp0 = z0 && l4 == 0;
        if (sp0) sm[0] = aA[0];
        bf16* o = Hb + (size_t)(NLAT + b * CTXL + kp) * DM + g * 512; v2u p;
        p.x = pk2(sm[0] * sc, sm[1] * sc); p.y = pk2(sm[2] * sc, sm[3] * sc); *(GAS v2u*)(o + pos) = p;
        bf16* mo = Hb + (size_t)(NLAT + b * CTXL + ((CTXL - kp) & (CTXL - 1))) * DM + g * 512 + 256 + pos;
        if (sp0) { *(GAS unsigned short*)(mo + 1) = (unsigned short)(p.x >> 16); *(GAS unsigned*)(mo + 2) = p.y; *(GAS unsigned short*)(o + 256) = (unsigned short)pk2(aBc[0] * sc, 0.f); }
        else *(GAS v2u*)(mo) = p; }
    __syncthreads();
}
DI void phase_fnet_s1(const Frame& F0, const Args& a, int with_ctx) {
    const Frame F = launder(F0);
    unsigned char* ws = launder_ptr(a.ws); const bf16* UC = (const bf16*)(ws + WS_UC); bf16* T = (bf16*)(ws + WS_T); bf16* Hb = (bf16*)(ws + WS_H);
    if (with_ctx) for (int unit = (int)blockIdx.x; unit < 128; unit += F.G) ctx_unit(F, UC, Hb, unit, (const bf16*)(ws + WS_MC));
    for (int cb = F.vcu; cb < 256; cb += F.G) { const int n2 = (cb >> 1) & 63; s1_pipe8(F, UC, T, cb * 8, (const bf16*)(ws + WS_M1) + (size_t)n2 * 128 * 64); }
}
DI void phase_fnet_s2(const Frame& F0, const Args& a) {
    const Frame F = launder(F0);
    unsigned char* ws = launder_ptr(a.ws); const SpecS2 sp{(const bf16*)(ws + WS_T), (bf16*)(ws + WS_H)};
    for (int cb = F.vcu; cb < 256; cb += F.G) dft_pipe16<64, SpecS2, 10>(F, sp, cb * 10, (const bf16*)(ws + WS_M2));
}

#define SITE(n) (((SITE_MASK) >> (n)) & 1u)
constexpr int N_PHASES = 2 + 10 * DEPTH - 1;
template <unsigned SITE_MASK> __global__ void __launch_bounds__(NWAVES * 64, 2) fwd_kernel(Args args) {
    extern __shared__ __attribute__((aligned(16))) unsigned char lds_raw[];
    Frame F; F.lds = (LAS unsigned char*)lds_raw;
    F.tid = threadIdx.x; F.lane = F.tid & 63; F.wave = __builtin_amdgcn_readfirstlane(F.tid >> 6);
    F.G = gridDim.x; { const int bx = blockIdx.x; F.vcu = (F.G % 8 == 0) ? (bx % 8) * (F.G / 8) + bx / 8 : bx; }
    unsigned char* ws = args.ws;
    volatile LAS unsigned* MISC = (volatile LAS unsigned*)(F.lds + MISC_OFF);
    for (int u = F.tid; u < (LDS_BYTES - MISC_OFF) / 4; u += NWAVES * 64) ((LAS unsigned*)(F.lds + MISC_OFF))[u] = 0u;
    __syncthreads();
    const int lo = args.ph_lo, hi = args.ph_hi;
    XcdBarrier bar; bar.bar = (unsigned*)(ws + WS_CTL) + CW_BAR; bar.x = 0; bar.st = nullptr;
    if (hi - lo > 1) bar = xcd_barrier_post((unsigned*)(ws + WS_CTL) + CW_BAR, MISC + 8);
#define IN(k) (lo <= (k) && (k) < hi)
#define SEAM(k) do { if (IN(k) && IN((k) + 1)) xcd_barrier(bar); } while (0)
#define WSP launder_ptr(args.ws)
#define mod ((const float*)(WSP + WS_MOD))
#define XA ((bf16*)(WSP + WS_XA))
#define Hb ((bf16*)(WSP + WS_H))
#define Yb ((bf16*)(WSP + WS_Y))
#define ACT ((bf16*)(WSP + WS_ACT))

    if (SITE(0) && IN(0)) for (int rep_ = 0, nrep_ = 1 + ((args.rep_mask >> 0) & 1); rep_ < nrep_; ++rep_) { phase_prologue(F, args); } SEAM(0);
    if (SITE(1) && IN(1)) for (int rep_ = 0, nrep_ = 1 + ((args.rep_mask >> 1) & 1); rep_ < nrep_; ++rep_) { phase_norm(F, MROWS, args.x, args.ctx, 0, nullptr, nullptr, nullptr, nullptr, nullptr, 0, Hb, args.norm_gains + 0 * DM, mod + 0 * DM, mod + 1 * DM); } SEAM(1);

    for (int li = 0; li < DEPTH; ++li) {
        const int pb = 2 + 10 * li; const int jl = li >> 1; const bool is_gla = (li & 1) == 0; const bool need_ctx = li < DEPTH - 1;
        const int nrows = li < 2 ? MROWS : NLAT;
        const int pms_in = li < 3 ? 272 : 256, pms_out = li < 2 ? 272 : 256;
        const float* modl = mod + (size_t)li * 3 * NADA; const float* gains = args.norm_gains + (size_t)li * 4 * DM;
        const void* xin_lat = li == 0 ? (const void*)args.x : (const void*)XA; const void* xin_ctx = li == 0 ? (const void*)args.ctx : (const void*)(XA + (size_t)NLAT * DM);
        if (is_gla) {
            const int colmajor = jl & 1;
            if (SITE(2) && IN(pb + 0)) for (int rep_ = 0, nrep_ = 1 + ((args.rep_mask >> 2) & 1); rep_ < nrep_; ++rep_) { pg8::Gemm g{Hb, (const bf16*)(WSP + WS_WIN) + (size_t)jl * GIN_PAD * DM, DM, DM, DM, 24, pms_in}; pg8::StaticOrder S; S.init(32, 24, F.G, (int)blockIdx.x);
                pg8::EpiWin E{(bf16*)(WSP + WS_Q), (bf16*)(WSP + WS_K), (bf16*)(WSP + WS_V), (bf16*)(WSP + WS_R), pms_in};
                pg8::gemm_phase<pg8::EpiWin, pg8::StaticOrder>(F.lds, g, S, E); phase_lr(F, args, jl); } SEAM(pb + 0);
            if (SITE(3) && IN(pb + 1)) for (int rep_ = 0, nrep_ = 1 + ((args.rep_mask >> 3) & 1); rep_ < nrep_; ++rep_) { phase_chunk_prep(F, args, jl, colmajor); } SEAM(pb + 1);
            if (SITE(4) && IN(pb + 2)) for (int rep_ = 0, nrep_ = 1 + ((args.rep_mask >> 4) & 1); rep_ < nrep_; ++rep_) { phase_scan(F, args, colmajor); } SEAM(pb + 2);
            if (SITE(5) && IN(pb + 3)) for (int rep_ = 0, nrep_ = 1 + ((args.rep_mask >> 5) & 1); rep_ < nrep_; ++rep_) { phase_gla_post(F, args, jl, nrows); } SEAM(pb + 3);
            if (SITE(6) && IN(pb + 4)) for (int rep_ = 0, nrep_ = 1 + ((args.rep_mask >> 6) & 1); rep_ < nrep_; ++rep_) { pg8::Gemm g{Hb, (const bf16*)(WSP + WS_WGO) + (size_t)jl * DM * DM, DM, DM, DM, 8, pms_out}; pg8::StaticOrder S; S.init(32, 8, F.G, (int)blockIdx.x);
                pg8::EpiBf16 E{Yb, DM, pms_out}; pg8::gemm_phase<pg8::EpiBf16, pg8::StaticOrder>(F.lds, g, S, E); } SEAM(pb + 4);
        } else {
            if (SITE(7) && IN(pb + 0)) for (int rep_ = 0, nrep_ = 1 + ((args.rep_mask >> 7) & 1); rep_ < nrep_; ++rep_) { pg8::Gemm g{Hb, (const bf16*)(WSP + WS_DFTC), 512, DM, 512, 2, pms_in}; pg8::StaticOrder S; S.init(32, 8, F.G, (int)blockIdx.x);
                pg8::EpiBf16 E{(bf16*)(WSP + WS_UC), 2048, pms_in}; pg8::gemm_phase<pg8::EpiBf16, pg8::StaticOrder>(F.lds, g, S, E); } SEAM(pb + 0);
            if (SITE(8) && IN(pb + 1)) for (int rep_ = 0, nrep_ = 1 + ((args.rep_mask >> 8) & 1); rep_ < nrep_; ++rep_) { phase_fnet_s1(F, args, need_ctx ? 1 : 0); } SEAM(pb + 1);
            if (SITE(9) && IN(pb + 2)) for (int rep_ = 0, nrep_ = 1 + ((args.rep_mask >> 9) & 1); rep_ < nrep_; ++rep_) { phase_fnet_s2(F, args); } SEAM(pb + 2);
            if (SITE(10) && IN(pb + 4)) for (int rep_ = 0, nrep_ = 1 + ((args.rep_mask >> 10) & 1); rep_ < nrep_; ++rep_) { pg8::Gemm g{Hb, (const bf16*)(WSP + WS_WFO) + (size_t)jl * DM * DM, DM, DM, DM, 8, pms_out}; pg8::StaticOrder S; S.init(32, 8, F.G, (int)blockIdx.x);
                pg8::EpiBf16 E{Yb, DM, pms_out}; pg8::gemm_phase<pg8::EpiBf16, pg8::StaticOrder>(F.lds, g, S, E); } SEAM(pb + 4);
        }
        if (SITE(11) && IN(pb + 5)) for (int rep_ = 0, nrep_ = 1 + ((args.rep_mask >> 11) & 1); rep_ < nrep_; ++rep_) { phase_norm(F, nrows, xin_lat, xin_ctx, li != 0, Yb, gains + 1 * DM, modl + 2 * DM, XA, XA + (size_t)NLAT * DM, 1, Hb, gains + 2 * DM, modl + 3 * DM, modl + 4 * DM); } SEAM(pb + 5);
        if (SITE(12) && IN(pb + 6)) for (int rep_ = 0, nrep_ = 1 + ((args.rep_mask >> 12) & 1); rep_ < nrep_; ++rep_) { pg8::Gemm g{Hb, (const bf16*)(WSP + WS_WGU) + (size_t)li * 2 * DFF * DM, DM, DM, DM, 44, 256}; pg8::StaticOrder S; S.init(li < 2 ? 34 : 32, li < 2 ? 44 : 40, F.G, (int)blockIdx.x);
            pg8::EpiSwiglu E{ACT, DFF, 256}; pg8::gemm_phase<pg8::EpiSwiglu, pg8::StaticOrder>(F.lds, g, S, E);
            if (li >= 2) { pg8::Gemm gh{Hb, (const bf16*)(WSP + WS_WGU) + ((size_t)li * 2 * DFF + 40 * 256) * DM, DM, DM, DM, 4, 256}; pg8::StaticOrder Sh; Sh.init(64, 4, F.G, (int)blockIdx.x);
                pg8::EpiSwigluH Eh{ACT + 40 * 128, DFF}; pg8::gemm_phase<pg8::EpiSwigluH, pg8::StaticOrder, true>(F.lds, gh, Sh, Eh); } } SEAM(pb + 6);
        if (SITE(13) && IN(pb + 7)) for (int rep_ = 0, nrep_ = 1 + ((args.rep_mask >> 13) & 1); rep_ < nrep_; ++rep_) { pg8::Gemm g{ACT, (const bf16*)(WSP + WS_WDN) + (size_t)li * DM * DFF, DFF, DFF, DFF, 8, pms_out}; pg8::StaticOrder S; S.init(32, 8, F.G, (int)blockIdx.x);
            pg8::EpiBf16 E{Yb, DM, pms_out}; pg8::gemm_phase<pg8::EpiBf16, pg8::StaticOrder>(F.lds, g, S, E); } SEAM(pb + 7);
        if (SITE(14) && IN(pb + 8)) for (int rep_ = 0, nrep_ = 1 + ((args.rep_mask >> 14) & 1); rep_ < nrep_; ++rep_) {
            if (li < DEPTH - 1) { const float* modn = mod + (size_t)(li + 1) * 3 * NADA; const float* gn = args.norm_gains + (size_t)(li + 1) * 4 * DM;
                phase_norm(F, nrows, XA, XA + (size_t)NLAT * DM, 1, Yb, gains + 3 * DM, modl + 5 * DM, XA, XA + (size_t)NLAT * DM, 1, Hb, gn, modn + 0 * DM, modn + 1 * DM); }
            else phase_norm(F, NLAT, XA, XA + (size_t)NLAT * DM, 1, Yb, gains + 3 * DM, modl + 5 * DM, args.out, args.out, 0, nullptr, nullptr, nullptr, nullptr);
        } SEAM(pb + 8);
    }
#undef IN
#undef SEAM
#undef WSP
#undef mod
#undef XA
#undef Hb
#undef Yb
#undef ACT
}

#if MK_N_LAUNCHES != 1
static int site_of_phase(int p) {
    if (p == 0) return 0; if (p == 1) return 1;
    const int rel = (p - 2) % 10, li = (p - 2) / 10; const bool gla = (li & 1) == 0;
    switch (rel) { case 0: return gla ? 2 : 7; case 1: return gla ? 3 : 8; case 2: return gla ? 4 : 9; case 3: return gla ? 5 : -1; case 4: return gla ? 6 : 10;
                   case 5: return 11; case 6: return 12; case 7: return 13; case 8: return 14; default: return -1; }
}
typedef void (*kern_t)(Args);
template <unsigned M> static kern_t kern_of() { return fwd_kernel<M>; }
static kern_t site_kernel(int site) {
    switch (site) { case 0: return kern_of<1u << 0>(); case 1: return kern_of<1u << 1>(); case 2: return kern_of<1u << 2>(); case 3: return kern_of<1u << 3>(); case 4: return kern_of<1u << 4>();
                    case 5: return kern_of<1u << 5>(); case 6: return kern_of<1u << 6>(); case 7: return kern_of<1u << 7>(); case 8: return kern_of<1u << 8>(); case 9: return kern_of<1u << 9>();
                    case 10: return kern_of<1u << 10>(); case 11: return kern_of<1u << 11>(); case 12: return kern_of<1u << 12>(); case 13: return kern_of<1u << 13>(); default: return kern_of<1u << 14>(); }
}
#endif
extern "C" void kernel_launch(void* const* d_in, const int* in_sizes, int n_in, void* d_out, int out_size, void* d_ws, size_t ws_size, hipStream_t stream) {
    static int grid = 0;
    if (grid == 0) {
        if (n_in != 17 || in_sizes[0] != NLAT * DM || out_size != NLAT * DM || ws_size < WS_END) {
            fprintf(stderr, "kernel_launch: unexpected shapes: n_in %d in0 %d out %d ws %zu (need %zu); nothing launched\n", n_in, n_in > 0 ? in_sizes[0] : -1, out_size, ws_size, (size_t)WS_END); grid = -1; return; }
        int dev = 0, cus = 0;
        if (hipGetDevice(&dev) != hipSuccess || hipDeviceGetAttribute(&cus, hipDeviceAttributeMultiprocessorCount, dev) != hipSuccess) { grid = -1; return; }
#if MK_N_LAUNCHES == 1
        if (hipFuncSetAttribute((const void*)fwd_kernel<FULL_MASK>, hipFuncAttributeMaxDynamicSharedMemorySize, LDS_BYTES) != hipSuccess) { fprintf(stderr, "kernel_launch: hipFuncSetAttribute failed\n"); grid = -1; return; }
#else
        for (int sidx = 0; sidx < 15; ++sidx) if (hipFuncSetAttribute((const void*)site_kernel(sidx), hipFuncAttributeMaxDynamicSharedMemorySize, LDS_BYTES) != hipSuccess) { fprintf(stderr, "kernel_launch: hipFuncSetAttribute failed\n"); grid = -1; return; }
#endif
        int occ = 0;
#if MK_N_LAUNCHES == 1
        if (hipOccupancyMaxActiveBlocksPerMultiprocessor(&occ, (const void*)fwd_kernel<FULL_MASK>, NWAVES * 64, LDS_BYTES) != hipSuccess || occ < 1) { fprintf(stderr, "kernel_launch: the occupancy query reports %d resident workgroups per CU; nothing launched\n", occ); grid = -1; return; }
#endif
        (void)hipGetLastError();
        grid = cus;
    }
    if (grid < 0) return;
    (void)hipMemsetAsync((char*)d_ws + WS_CTL, 0, CTL_ZERO_BYTES, stream);
    Args a{};
    a.x = (const float*)d_in[0]; a.c = (const float*)d_in[1]; a.ctx = (const float*)d_in[2]; a.c_ctx = (const float*)d_in[3]; a.ada_w = (const float*)d_in[4]; a.ada_b = (const float*)d_in[5];
    a.norm_gains = (const float*)d_in[6]; a.gla_w_in = (const float*)d_in[7]; a.gla_wg2_f = (const float*)d_in[8]; a.gla_bg_f = (const float*)d_in[9]; a.gla_wg2_b = (const float*)d_in[10]; a.gla_bg_b = (const float*)d_in[11];
    a.gla_head_gain = (const float*)d_in[12]; a.gla_w_out = (const float*)d_in[13]; a.fnet_w_out = (const float*)d_in[14]; a.ffn_w_gu = (const float*)d_in[15]; a.ffn_w_down = (const float*)d_in[16];
    a.out = (float*)d_out; a.ws = (unsigned char*)d_ws; a.rep_mask = PROBE_REP_MASK;
#if MK_N_LAUNCHES == 1
    a.ph_lo = 0; a.ph_hi = N_PHASES;
    hipLaunchKernelGGL(fwd_kernel<FULL_MASK>, dim3(grid), dim3(NWAVES * 64), LDS_BYTES, stream, a);
#else
    for (int p = 0; p < N_PHASES; ++p) {
        const int site = site_of_phase(p); if (site < 0) continue;
        a.ph_lo = p; a.ph_hi = p + 1;
        hipLaunchKernelGGL(site_kernel(site), dim3(grid), dim3(NWAVES * 64), LDS_BYTES, stream, a);
    }
#endif
}
```

```cpp
#include <hip/hip_runtime.h>
#include <cstdio>
#include <cstdint>

#ifndef FULL_MASK
#define FULL_MASK 0xFFFFFFFFu
#endif
#ifndef MK_N_LAUNCHES
#define MK_N_LAUNCHES 1
#endif
#ifndef PROBE_REP_MASK
#define PROBE_REP_MASK 0
#endif

constexpr int DM = 2048, BATCH = 2, SEQ = 4096, DEPTH = 4, CTXL = 256;
constexpr int NLAT = BATCH * SEQ, NCTX = BATCH * CTXL, MROWS = NLAT + NCTX;
constexpr int KD = 1024, VD = 2048, NH = 4, HK = 256, HV = 512, GR = 16;
constexpr int GIN = 2 * KD + 2 * VD + 2 * GR;
constexpr int GIN_PAD = 6400;
constexpr int DFF = 5632, NADA = 6 * DM;
constexpr float EPS = 1e-6f;
constexpr int NCHUNK = 68;
constexpr int NCG = BATCH * NCHUNK;

constexpr size_t al256(size_t x) { return (x + 255) & ~(size_t)255; }
constexpr size_t WS_CTL = 0, CTL_ZERO_BYTES = 65536;
constexpr size_t WS_MOD = WS_CTL + CTL_ZERO_BYTES;
constexpr size_t WS_WIN = al256(WS_MOD + (size_t)DEPTH * 3 * NADA * 4);
constexpr size_t WS_WGO = al256(WS_WIN + (size_t)2 * GIN_PAD * DM * 2);
constexpr size_t WS_WFO = al256(WS_WGO + (size_t)2 * DM * DM * 2);
constexpr size_t WS_WGU = al256(WS_WFO + (size_t)2 * DM * DM * 2);
constexpr size_t WS_WDN = al256(WS_WGU + (size_t)DEPTH * 2 * DFF * DM * 2);
constexpr size_t WS_DFTC = al256(WS_WDN + (size_t)DEPTH * DM * DFF * 2);
constexpr size_t WS_M1 = al256(WS_DFTC + (size_t)1024 * 512 * 2);
constexpr size_t WS_M2 = al256(WS_M1 + (size_t)64 * 128 * 128 * 2);
constexpr size_t WS_MC = al256(WS_M2 + (size_t)64 * 128 * 2);
constexpr size_t WS_XA = al256(WS_MC + (size_t)256 * 512 * 2);
constexpr size_t WS_H = al256(WS_XA + (size_t)MROWS * DM * 4);
constexpr size_t WS_Q = al256(WS_H + (size_t)MROWS * DM * 2);
constexpr size_t WS_K = al256(WS_Q + (size_t)MROWS * KD * 2);
constexpr size_t WS_V = al256(WS_K + (size_t)MROWS * KD * 2);
constexpr size_t WS_R = al256(WS_V + (size_t)MROWS * VD * 2);
constexpr size_t WS_LR = al256(WS_R + (size_t)MROWS * VD * 2);
constexpr size_t WS_QD = al256(WS_LR + (size_t)MROWS * 32 * 4);
constexpr size_t WS_KET = al256(WS_QD + (size_t)2 * MROWS * KD * 2);
constexpr size_t WS_VT = al256(WS_KET + (size_t)2 * NCG * NH * HK * 64 * 2);
constexpr size_t WS_AM = al256(WS_VT + (size_t)NCG * VD * 64 * 2);
constexpr size_t WS_DEC = al256(WS_AM + (size_t)2 * NCG * NH * 64 * 64 * 2);
constexpr size_t WS_O = al256(WS_DEC + (size_t)2 * NCG * NH * HK * 4);
constexpr size_t WS_Y = al256(WS_O + (size_t)2 * MROWS * VD * 2);
constexpr size_t WS_ACT = al256(WS_Y + (size_t)MROWS * DM * 2);
constexpr size_t WS_UC = al256(WS_ACT + (size_t)MROWS * DFF * 2);
constexpr size_t WS_T = al256(WS_UC + (size_t)MROWS * 4096 * 2);
constexpr size_t WS_END = al256(WS_T + (size_t)NLAT * 4096 * 2);
constexpr int CW_BAR = 1024;

constexpr int RING_BYTES = 131072;
constexpr int LDS_BYTES = 163840;
constexpr int MISC_OFF = LDS_BYTES - 512;
constexpr int NWAVES = 8;

#define GAS __attribute__((address_space(1)))
#define LAS __attribute__((address_space(3)))
typedef unsigned short bf16;
typedef unsigned v4u __attribute__((ext_vector_type(4)));
typedef unsigned v2u __attribute__((ext_vector_type(2)));
typedef float f32x4 __attribute__((ext_vector_type(4)));
typedef short bf16x8 __attribute__((ext_vector_type(8)));
typedef short s16x4 __attribute__((ext_vector_type(4)));
#define RLX_AGENT __ATOMIC_RELAXED, __HIP_MEMORY_SCOPE_AGENT
#define LDS_WAIT() asm volatile("s_waitcnt lgkmcnt(0)" ::: "memory")
#define VM_WAIT() asm volatile("s_waitcnt vmcnt(0)" ::: "memory")
#define DI __device__ __forceinline__

DI unsigned f2bf(float f) { unsigned u = __builtin_bit_cast(unsigned, f); return (u + 0x7fffu + ((u >> 16) & 1u)) >> 16; }
typedef float f32x2_t __attribute__((ext_vector_type(2))); typedef __bf16 bf16x2_t __attribute__((ext_vector_type(2)));
DI unsigned pk2(float lo, float hi) { f32x2_t v = {lo, hi}; bf16x2_t b = __builtin_convertvector(v, bf16x2_t); return __builtin_bit_cast(unsigned, b); }
DI float bf2f(unsigned short b) { return __builtin_bit_cast(float, (unsigned)b << 16); }
DI float bflo(unsigned w) { return __builtin_bit_cast(float, w << 16); }
DI float bfhi(unsigned w) { return __builtin_bit_cast(float, w & 0xffff0000u); }
DI float wave_sum(float v) {
#pragma unroll
    for (int o = 1; o < 64; o <<= 1) v += __shfl_xor(v, o);
    return v;
}
DI float silu_f(float x) { return x * __builtin_amdgcn_rcpf(1.0f + __expf(-x)); }
DI bf16x8 ld_frag_g(const bf16* p) { return *(const GAS bf16x8*)p; }
DI bf16x8 ld_frag_l(const LAS unsigned char* p) { return *(const LAS bf16x8*)p; }
DI s16x4 vtr(const LAS unsigned char* p) { return __builtin_bit_cast(s16x4, __builtin_amdgcn_ds_read_tr16_b64_v4i16((LAS s16x4*)p)); }
DI f32x4 mfma16(bf16x8 a, bf16x8 b, f32x4 c) { return __builtin_amdgcn_mfma_f32_16x16x32_bf16(a, b, c, 0, 0, 0); }

namespace pg8 {
#define PG8_LAS __attribute__((address_space(3)))
typedef unsigned short bf16_t;
typedef unsigned u32x4 __attribute__((ext_vector_type(4)));
typedef unsigned u32x2 __attribute__((ext_vector_type(2)));
constexpr int BM = 256, BK = 64, HALF = 128, HTB = HALF * BK * 2, STAGE_BYTES = 8 * HTB, NXCD = 8, WGM = 8, PMS = 272;
constexpr int XOFF = 132096;
__host__ __device__ __forceinline__ int lds_byte(int r, int c) { const int st = (r >> 4) * 2 + (c >> 5), rr = r & 15, cc = c & 31, ob = rr * 64 + cc * 2; return st * 1024 + (ob ^ (((ob >> 9) & 1) << 5)); }
__host__ __device__ __forceinline__ void stage_rc(int b, int& R, int& C) { const int st = b / 1024, sb = b % 1024, swz = sb ^ (((sb >> 9) & 1) << 5); R = (st >> 1) * 16 + swz / 64; C = (st & 1) * 32 + (swz % 64) / 2; }
__host__ __device__ __forceinline__ int perm32(int rho) { const int n = rho >> 4, i = rho & 15; return 8 * (i >> 2) + 4 * n + (i & 3); }
struct Unit { int pm, pn; };
struct Gemm { const bf16_t* A; const bf16_t* Bt; int K, lda, ldb, npg, pms; };
struct StaticOrder {
    int nM, nN, nwg, G, c;
    __host__ __device__ void init(int nM_, int nN_, int G_, int c_) { nM = nM_; nN = nN_; nwg = nM * nN; G = G_; c = c_; }
    __host__ __device__ bool next(int i, Unit& u) const {
        const long L = (long)i * G + c; if (L >= nwg) return false;
        int wgid = (int)L; { const int q = nwg / NXCD, r = nwg % NXCD, xcd = wgid % NXCD, off = wgid / NXCD; wgid = (xcd < r ? xcd * (q + 1) : r * (q + 1) + (xcd - r) * q) + off; }
        const int nig = WGM * nN, gid = wgid / nig, fm = gid * WGM, gsz = (nM - fm) < WGM ? (nM - fm) : WGM;
        u.pm = fm + ((wgid % nig) % gsz); u.pn = (wgid % nig) / gsz; return true;
    }
    __device__ __forceinline__ void a_ready(const Unit&) const {}
    __device__ __forceinline__ void done(const Unit&) const {}
};
__device__ __forceinline__ unsigned cvt_pk_bf16(float lo, float hi) { unsigned r; asm volatile("v_cvt_pk_bf16_f32 %0, %1, %2" : "=v"(r) : "v"(lo), "v"(hi)); return r; }

struct EpiBf16 {
    static constexpr bool PERM = true;
    bf16_t* O; int ldc, pms;
    __device__ __forceinline__ void operator()(const f32x4 (&acc)[2][2][4][2], const f32x4 (&accx)[2], const Unit& u, int wr, int wc, int fr, int fq) const {
        const int row0 = u.pm * pms + wr * 64 + fr, col0 = u.pn * BM + wc * 32 + 8 * fq;
#pragma unroll
        for (int ai = 0; ai < 2; ++ai)
#pragma unroll
            for (int m = 0; m < 4; ++m) { bf16_t* rowp = O + (size_t)(row0 + ai * HALF + m * 16) * ldc + col0;
#pragma unroll
                for (int bj = 0; bj < 2; ++bj) { const f32x4 v0 = acc[ai][bj][m][0], v1 = acc[ai][bj][m][1];
                    u32x4 w; w.x = cvt_pk_bf16(v0[0], v0[1]); w.y = cvt_pk_bf16(v0[2], v0[3]); w.z = cvt_pk_bf16(v1[0], v1[1]); w.w = cvt_pk_bf16(v1[2], v1[3]);
                    *(GAS u32x4*)(rowp + bj * HALF) = w; } }
        if (pms == BM) return;
        bf16_t* xrow = O + (size_t)(u.pm * pms + 256 + fr) * ldc + col0 + 4 * wr;
#pragma unroll
        for (int bj = 0; bj < 2; ++bj) { u32x2 w; w.x = cvt_pk_bf16(accx[bj][0], accx[bj][1]); w.y = cvt_pk_bf16(accx[bj][2], accx[bj][3]); *(GAS u32x2*)(xrow + bj * HALF) = w; }
    }
};
struct EpiWin {
    static constexpr bool PERM = true;
    bf16_t *Q, *K, *V, *R; int pms;
    __device__ __forceinline__ void operator()(const f32x4 (&acc)[2][2][4][2], const f32x4 (&accx)[2], const Unit& u, int wr, int wc, int fr, int fq) const {
        const int row0 = u.pm * pms + wr * 64 + fr; const int pn = u.pn;
        bf16_t* base; int ldc, colt; float sc = 1.0f;
        if (pn < 4) { base = Q; ldc = KD; colt = pn * BM; sc = 0.0625f; }
        else if (pn < 8) { base = K; ldc = KD; colt = (pn - 4) * BM; }
        else if (pn < 16) { base = V; ldc = VD; colt = (pn - 8) * BM; }
        else { base = R; ldc = VD; colt = (pn - 16) * BM; }
        const int col0 = colt + wc * 32 + 8 * fq;
#pragma unroll
        for (int ai = 0; ai < 2; ++ai)
#pragma unroll
            for (int m = 0; m < 4; ++m) { bf16_t* rowp = base + (size_t)(row0 + ai * HALF + m * 16) * ldc + col0;
#pragma unroll
                for (int bj = 0; bj < 2; ++bj) { const f32x4 v0 = acc[ai][bj][m][0] * sc, v1 = acc[ai][bj][m][1] * sc;
                    u32x4 w; w.x = cvt_pk_bf16(v0[0], v0[1]); w.y = cvt_pk_bf16(v0[2], v0[3]); w.z = cvt_pk_bf16(v1[0], v1[1]); w.w = cvt_pk_bf16(v1[2], v1[3]);
                    *(GAS u32x4*)(rowp + bj * HALF) = w; } }
        if (pms == BM) return;
        bf16_t* xrow = base + (size_t)(u.pm * pms + 256 + fr) * ldc + col0 + 4 * wr;
#pragma unroll
        for (int bj = 0; bj < 2; ++bj) { const f32x4 v = accx[bj] * sc; u32x2 w; w.x = cvt_pk_bf16(v[0], v[1]); w.y = cvt_pk_bf16(v[2], v[3]); *(GAS u32x2*)(xrow + bj * HALF) = w; }
    }
};
struct EpiSwiglu {
    static constexpr bool PERM = true;
    bf16_t* O; int ldc, pms;
    __device__ __forceinline__ void operator()(const f32x4 (&acc)[2][2][4][2], const f32x4 (&accx)[2], const Unit& u, int wr, int wc, int fr, int fq) const {
        const int row0 = u.pm * pms + wr * 64 + fr, col0 = u.pn * HALF + wc * 32 + 8 * fq;
#pragma unroll
        for (int ai = 0; ai < 2; ++ai)
#pragma unroll
            for (int m = 0; m < 4; ++m) { bf16_t* rowp = O + (size_t)(row0 + ai * HALF + m * 16) * ldc + col0;
                f32x4 v0, v1;
#pragma unroll
                for (int j = 0; j < 4; ++j) { const float g0 = acc[ai][0][m][0][j], g1 = acc[ai][0][m][1][j];
                    v0[j] = g0 * __builtin_amdgcn_rcpf(1.0f + __expf(-g0)) * acc[ai][1][m][0][j];
                    v1[j] = g1 * __builtin_amdgcn_rcpf(1.0f + __expf(-g1)) * acc[ai][1][m][1][j]; }
                u32x4 w; w.x = cvt_pk_bf16(v0[0], v0[1]); w.y = cvt_pk_bf16(v0[2], v0[3]); w.z = cvt_pk_bf16(v1[0], v1[1]); w.w = cvt_pk_bf16(v1[2], v1[3]);
                *(GAS u32x4*)(rowp) = w; }
        if (pms == BM) return;
        f32x4 v;
#pragma unroll
        for (int j = 0; j < 4; ++j) { const float g0 = accx[0][j]; v[j] = g0 * __builtin_amdgcn_rcpf(1.0f + __expf(-g0)) * accx[1][j]; }
        u32x2 w; w.x = cvt_pk_bf16(v[0], v[1]); w.y = cvt_pk_bf16(v[2], v[3]);
        *(GAS u32x2*)(O + (size_t)(u.pm * pms + 256 + fr) * ldc + col0 + 4 * wr) = w;
    }
};

struct EpiSwigluH {
    static constexpr bool PERM = true;
    bf16_t* O; int ldc;
    __device__ __forceinline__ void operator()(const f32x4 (&acc)[2][2][4][2], const f32x4 (&)[2], const Unit& u, int wr, int wc, int fr, int fq) const {
        const int row0 = u.pm * HALF + wr * 64 + fr, col0 = u.pn * HALF + wc * 32 + 8 * fq;
#pragma unroll
        for (int m = 0; m < 4; ++m) { bf16_t* rowp = O + (size_t)(row0 + m * 16) * ldc + col0;
            f32x4 v0, v1;
#pragma unroll
            for (int j = 0; j < 4; ++j) { const float g0 = acc[0][0][m][0][j], g1 = acc[0][0][m][1][j];
                v0[j] = g0 * __builtin_amdgcn_rcpf(1.0f + __expf(-g0)) * acc[0][1][m][0][j];
                v1[j] = g1 * __builtin_amdgcn_rcpf(1.0f + __expf(-g1)) * acc[0][1][m][1][j]; }
            u32x4 w; w.x = cvt_pk_bf16(v0[0], v0[1]); w.y = cvt_pk_bf16(v0[2], v0[3]); w.z = cvt_pk_bf16(v1[0], v1[1]); w.w = cvt_pk_bf16(v1[2], v1[3]);
            *(GAS u32x4*)(rowp) = w; }
    }
};

__device__ __forceinline__ void glds16_s(unsigned voff, const void* sbase, unsigned lds_dst) { unsigned keep;
    asm volatile("s_mov_b32 %0, m0\n\ts_mov_b32 m0, %3\n\ts_nop 0\n\tglobal_load_lds_dwordx4 %1, %2\n\ts_mov_b32 m0, %0" : "=&s"(keep) : "v"(voff), "s"(sbase), "s"(lds_dst) : "memory"); }
template <class Epi, class Sched, bool HM = false>
__device__ __forceinline__ void gemm_phase(PG8_LAS unsigned char* lds, const Gemm g, const Sched& S, const Epi& E) {
    int tid_ = threadIdx.x; asm volatile("; launder tid" : "+v"(tid_));
    const int tid = tid_, wid = __builtin_amdgcn_readfirstlane(tid >> 6), lane = tid & 63, wr = wid >> 2, wc = wid & 3, fr = lane & 15, fq = lane >> 4;
    const int K = g.K, nt = K / BK;
    unsigned voffA[2], voffB[2];
#pragma unroll
    for (int i = 0; i < 2; ++i) { int R, C; stage_rc(tid * 16 + i * 8192, R, C); const int Rb = Epi::PERM ? ((R & ~31) + perm32(R & 31)) : R;
        voffA[i] = (unsigned)(R * g.lda + C) * 2u; voffB[i] = (unsigned)(Rb * g.ldb + C) * 2u; }
    const unsigned voffX = (unsigned)((4 * (wid & 3) + (lane >> 4)) * g.lda + 8 * (lane & 15)) * 2u;
    const size_t kstep = (size_t)(BK * 2);
    const size_t hstepA = (size_t)HALF * g.lda * 2, hstepB = (size_t)HALF * g.ldb * 2;
    const size_t tstepA = (size_t)(HM ? HALF : g.pms) * g.lda * 2, tstepB = 2 * hstepB, xstep = 2 * hstepA; const bool hasx = g.pms != BM;
    const unsigned ldsw = (unsigned)wid * 1024u, ldsx = (unsigned)(wid & 3) * 1024u;
    const unsigned ldsbase = (unsigned)__builtin_amdgcn_readfirstlane((int)(unsigned)(__UINTPTR_TYPE__)lds);
    const int aoff = lds_byte(wr * 64 + fr, fq * 8), boff = lds_byte(wc * 32 + fr, fq * 8);
    const int xoff = XOFF + fr * 256 + fq * 16;
#define PG8_SA(b, h) (((b) * 2 + (h)) * HTB)
#define PG8_SB(b, h) ((4 + (b) * 2 + (h)) * HTB)
#define PG8_STAGE(bufoff, gbase, voff) do { _Pragma("unroll") for (int _i = 0; _i < 2; ++_i) glds16_s((voff)[_i], (const void*)(gbase), ldsbase + (unsigned)((bufoff) + _i * 8192) + ldsw); } while (0)
#define PG8_STAGEX(pb, gbase) glds16_s(voffX, (const void*)(gbase), ldsbase + (unsigned)(XOFF + (pb) * 4096) + ldsx)
#define PG8_LDA(dst, b, h) do { _Pragma("unroll") for (int m = 0; m < 4; ++m) _Pragma("unroll") for (int k = 0; k < 2; ++k) dst[m][k] = *(const PG8_LAS bf16x8*)(lds + PG8_SA(b, h) + aoff + m * 2048 + k * 1024); } while (0)
#define PG8_LDB(dst, b, h) do { _Pragma("unroll") for (int n = 0; n < 2; ++n) _Pragma("unroll") for (int k = 0; k < 2; ++k) dst[n][k] = *(const PG8_LAS bf16x8*)(lds + PG8_SB(b, h) + boff + n * 2048 + k * 1024); } while (0)
#define PG8_LDX(pb, tp) do { _Pragma("unroll") for (int k = 0; k < 2; ++k) Ax[k] = *(const PG8_LAS bf16x8*)(lds + xoff + (pb) * 4096 + (tp) * 128 + k * 64); } while (0)
#define PG8_MMA(ai, bj, At, Bt) do { __builtin_amdgcn_s_setprio(1); _Pragma("unroll") for (int m = 0; m < 4; ++m) _Pragma("unroll") for (int n = 0; n < 2; ++n) _Pragma("unroll") for (int k = 0; k < 2; ++k) \
        acc[ai][bj][m][n] = __builtin_amdgcn_mfma_f32_16x16x32_bf16(Bt[n][k], At[m][k], acc[ai][bj][m][n], 0, 0, 0); __builtin_amdgcn_s_setprio(0); } while (0)
#define PG8_MMAX() do { if (wr) { _Pragma("unroll") for (int k = 0; k < 2; ++k) { \
        accx[0] = __builtin_amdgcn_mfma_f32_16x16x32_bf16(B0[1][k], Ax[k], accx[0], 0, 0, 0); accx[1] = __builtin_amdgcn_mfma_f32_16x16x32_bf16(B1[1][k], Ax[k], accx[1], 0, 0, 0); } } \
    else { _Pragma("unroll") for (int k = 0; k < 2; ++k) { \
        accx[0] = __builtin_amdgcn_mfma_f32_16x16x32_bf16(B0[0][k], Ax[k], accx[0], 0, 0, 0); accx[1] = __builtin_amdgcn_mfma_f32_16x16x32_bf16(B1[0][k], Ax[k], accx[1], 0, 0, 0); } } } while (0)
#define PG8_WAIT_V(n) asm volatile("s_waitcnt vmcnt(" #n ")" ::: "memory")
#define PG8_WAIT_L(n) asm volatile("s_waitcnt lgkmcnt(" #n ")" ::: "memory")
#define PG8_BAR __builtin_amdgcn_s_barrier()
#define PG8_SCHED __builtin_amdgcn_sched_barrier(0)
#define PG8_APTR(u) ((const char*)g.A + (size_t)(u).pm * tstepA + (size_t)((u).pn / g.npg) * K * 2)
#define PG8_BPTR(u) ((const char*)g.Bt + (size_t)((u).pn % g.npg) * tstepB)
    Unit cur, nxt; int ui = 0;
    if (!S.next(0, cur)) return;
    f32x4 acc[2][2][4][2]; f32x4 accx[2];
#pragma unroll
    for (int a = 0; a < 2; ++a)
#pragma unroll
        for (int b = 0; b < 2; ++b)
#pragma unroll
            for (int m = 0; m < 4; ++m)
#pragma unroll
                for (int n = 0; n < 2; ++n) acc[a][b][m][n] = (f32x4){0.f, 0.f, 0.f, 0.f};
    accx[0] = (f32x4){0.f, 0.f, 0.f, 0.f}; accx[1] = accx[0];
    bf16x8 At[4][2], B0[2][2], B1[2][2], Ax[2];
    const char* cA = PG8_APTR(cur); const char* cB = PG8_BPTR(cur);
    S.a_ready(cur);
    PG8_STAGE(PG8_SB(0, 0), cB, voffB); PG8_STAGE(PG8_SB(0, 1), cB + hstepB, voffB); PG8_STAGE(PG8_SA(0, 0), cA, voffA); PG8_STAGEX(0, cA + xstep); PG8_STAGE(PG8_SA(0, 1), cA + hstepA, voffA);
    if (wr == 1) PG8_BAR;
    PG8_WAIT_V(2); PG8_BAR;
    PG8_STAGE(PG8_SB(1, 0), cB + kstep, voffB); PG8_STAGE(PG8_SA(1, 0), cA + kstep, voffA); PG8_STAGE(PG8_SB(1, 1), cB + hstepB + kstep, voffB);
    PG8_WAIT_V(6); PG8_BAR;
    for (;;) {
        const bool has_next = S.next(ui + 1, nxt);
        const char* nA = has_next ? PG8_APTR(nxt) : cA; const char* nB = has_next ? PG8_BPTR(nxt) : cB;
        for (int t = 0; t < nt; t += 2) {
            const bool last = (t == nt - 2);
            const char* a1 = cA + (size_t)(t + 1) * kstep;
            const char* a2 = last ? nA : cA + (size_t)(t + 2) * kstep; const char* b2 = last ? nB : cB + (size_t)(t + 2) * kstep;
            const char* a3 = a2 + kstep; const char* b3 = b2 + kstep;
            asm volatile("; uniform bases" : "+s"(a1), "+s"(a2), "+s"(a3), "+s"(b2), "+s"(b3));
            if (last && has_next) S.a_ready(nxt);
            const int pb = (t >> 1) & 1;
            PG8_LDB(B0, 0, 0); PG8_LDB(B1, 0, 1); PG8_SCHED; PG8_LDA(At, 0, 0); if (hasx) PG8_LDX(pb, 0); PG8_STAGE(PG8_SA(1, 1), a1 + hstepA, voffA); PG8_STAGEX(pb ^ 1, a2 + xstep);
            PG8_WAIT_V(9); PG8_WAIT_L(0); PG8_BAR; PG8_MMA(0, 0, At, B0); PG8_MMA(0, 1, At, B1); if (hasx) PG8_MMAX(); PG8_BAR; PG8_SCHED;
            if (!HM) PG8_LDA(At, 0, 1); PG8_STAGE(PG8_SB(0, 0), b2, voffB); PG8_STAGE(PG8_SB(0, 1), b2 + hstepB, voffB); PG8_STAGE(PG8_SA(0, 0), a2, voffA);
            PG8_WAIT_V(9); PG8_WAIT_L(0); PG8_BAR; if (!HM) { PG8_MMA(1, 0, At, B0); PG8_MMA(1, 1, At, B1); } PG8_BAR; PG8_SCHED;
            PG8_LDB(B0, 1, 0); PG8_LDB(B1, 1, 1); PG8_SCHED; PG8_LDA(At, 1, 0); if (hasx) PG8_LDX(pb, 1); PG8_STAGE(PG8_SA(0, 1), a2 + hstepA, voffA);
            PG8_WAIT_V(9); PG8_WAIT_L(0); PG8_BAR; PG8_MMA(0, 0, At, B0); PG8_MMA(0, 1, At, B1); if (hasx) PG8_MMAX(); PG8_BAR; PG8_SCHED;
            if (!HM) PG8_LDA(At, 1, 1); PG8_STAGE(PG8_SB(1, 0), b3, voffB); PG8_STAGE(PG8_SB(1, 1), b3 + hstepB, voffB); PG8_STAGE(PG8_SA(1, 0), a3, voffA);
            PG8_WAIT_V(8); PG8_WAIT_L(0); PG8_BAR; if (!HM) { PG8_MMA(1, 0, At, B0); PG8_MMA(1, 1, At, B1); } PG8_BAR; PG8_SCHED;
        }
        if (wr == 0) PG8_BAR;
        E(acc, accx, cur, wr, wc, fr, fq); S.done(cur);
        if (!has_next) break;
#pragma unroll
        for (int a = 0; a < 2; ++a)
#pragma unroll
            for (int b = 0; b < 2; ++b)
#pragma unroll
                for (int m = 0; m < 4; ++m)
#pragma unroll
                    for (int n = 0; n < 2; ++n) acc[a][b][m][n] = (f32x4){0.f, 0.f, 0.f, 0.f};
        accx[0] = (f32x4){0.f, 0.f, 0.f, 0.f}; accx[1] = accx[0];
        cur = nxt; cA = nA; cB = nB; ++ui;
        if (wr == 1) PG8_BAR;
    }
    PG8_WAIT_V(0);
    PG8_BAR;
#undef PG8_SA
#undef PG8_SB
#undef PG8_STAGE
#undef PG8_STAGEX
#undef PG8_LDA
#undef PG8_LDB
#undef PG8_LDX
#undef PG8_MMA
#undef PG8_MMAX
#undef PG8_WAIT_V
#undef PG8_WAIT_L
#undef PG8_BAR
#undef PG8_SCHED
#undef PG8_APTR
#undef PG8_BPTR
}
}

#define XB_TMO      128
#define XB_XCNT(j)  (256  + 64 * (j))
#define XB_XSUB(j)  (1280 + 64 * (j))
#define XB_XGEN(j)  (2304 + 64 * (j))
#define XB_TOP      3328
#define XB_TOPGEN   3392
#define XCD_BAR_WORDS 3456
#define XB_SPIN_CAP (1u << 18)
__device__ __forceinline__ unsigned xb_ld(unsigned* p)              { return __hip_atomic_load(p, __ATOMIC_RELAXED, __HIP_MEMORY_SCOPE_AGENT); }
__device__ __forceinline__ unsigned xb_add(unsigned* p, unsigned v) { return __hip_atomic_fetch_add(p, v, __ATOMIC_RELAXED, __HIP_MEMORY_SCOPE_AGENT); }
__device__ __forceinline__ unsigned xb_xcc_id() { return (unsigned)__builtin_amdgcn_s_getreg((3 << 11) | 20) & 0xFu; }
#define XB_SPIN(cond, bar) do { unsigned _sp = 0; while (cond) { __builtin_amdgcn_s_sleep(1); \
    if ((++_sp & 255u) == 0u) { if (xb_ld(&(bar)[XB_TMO])) break; if (_sp > XB_SPIN_CAP) { atomicAdd(&(bar)[XB_TMO], 1u); break; } } } } while (0)
struct XcdBarrier { unsigned* bar; unsigned x; volatile LAS unsigned* st; };
__device__ __forceinline__ XcdBarrier xcd_barrier_post(unsigned* bar, volatile LAS unsigned* st) {
    XcdBarrier b; b.bar = bar; b.x = xb_xcc_id(); b.st = st;
    if (threadIdx.x == 0) (void)xb_add(&bar[XB_XCNT(b.x)], 1u);
    return b;
}
__device__ __forceinline__ void xcd_barrier_complete(unsigned* bar, unsigned x, unsigned& nloc, unsigned& nx) {
    const unsigned G = gridDim.x * gridDim.y * gridDim.z;
    unsigned sum, cnt, mine, sp = 0u;
    for (;;) {
        sum = 0u; cnt = 0u; mine = 0u;
#pragma unroll
        for (unsigned j = 0; j < 16; ++j) { const unsigned c = xb_ld(&bar[XB_XCNT(j)]); sum += c; cnt += (c > 0u) ? 1u : 0u; mine = (j == x) ? c : mine; }
        if (sum == G) break;
        __builtin_amdgcn_s_sleep(1);
        if ((++sp & 255u) == 0u) { if (xb_ld(&bar[XB_TMO])) break; if (sp > XB_SPIN_CAP) { atomicAdd(&bar[XB_TMO], 1u); break; } }
    }
    nloc = mine > 0u ? mine : 1u; nx = cnt > 0u ? cnt : 1u;
}
__device__ __forceinline__ void xcd_barrier(const XcdBarrier& b) {
    asm volatile("s_waitcnt vmcnt(0)" ::: "memory");
    __syncthreads();
    if (threadIdx.x == 0) {
        unsigned* bar = b.bar;
        __builtin_amdgcn_s_waitcnt(0);
        unsigned nloc = b.st[0], nx = b.st[1];
        if (nloc == 0u) { xcd_barrier_complete(bar, b.x, nloc, nx); b.st[0] = nloc; b.st[1] = nx; }
        const unsigned old = xb_add(&bar[XB_XSUB(b.x)], 1u);
        const unsigned gen = old / nloc;
        if (old + 1u == (gen + 1u) * nloc) {
            __builtin_amdgcn_fence(__ATOMIC_RELEASE, "agent");
            asm volatile("s_waitcnt vmcnt(0)" ::: "memory");
            const unsigned og = xb_add(&bar[XB_TOP], 1u);
            const unsigned tg = og / nx;
            if (og + 1u == (tg + 1u) * nx) xb_add(&bar[XB_TOPGEN], 1u);
            else XB_SPIN(xb_ld(&bar[XB_TOPGEN]) == tg, bar);
            __builtin_amdgcn_fence(__ATOMIC_ACQUIRE, "agent");
            xb_add(&bar[XB_XGEN(b.x)], 1u);
            asm volatile("s_waitcnt vmcnt(0)" ::: "memory");
        } else {
            XB_SPIN(xb_ld(&bar[XB_XGEN(b.x)]) == gen, bar);
            __builtin_amdgcn_fence(__ATOMIC_ACQUIRE, "agent");
            asm volatile("s_waitcnt vmcnt(0)" ::: "memory");
        }
    }
    __syncthreads();
}

struct Args {
    const float *x, *c, *ctx, *c_ctx, *ada_w, *ada_b, *norm_gains, *gla_w_in, *gla_wg2_f, *gla_bg_f, *gla_wg2_b, *gla_bg_b, *gla_head_gain, *gla_w_out, *fnet_w_out, *ffn_w_gu, *ffn_w_down;
    float* out; unsigned char* ws; int ph_lo, ph_hi, rep_mask, pad;
};
struct Frame {
    LAS unsigned char* lds;
    int tid, lane, wave, vcu, G;
};

DI unsigned char* launder_ptr(unsigned char* p) { asm volatile("; launder ptr" : "+s"(p)); return p; }
DI Frame launder(const Frame& F0) { Frame F = F0; asm volatile("; launder frame" : "+v"(F.tid), "+v"(F.lane), "+s"(F.wave), "+s"(F.vcu)); return F; }
DI int row_mb(int R) { return R < SEQ ? 0 : (R < NLAT ? 1 : 2); }

DI int fnet_chan(int p) { return p <= 256 ? p : 768 - p; }
DI void transpose_item(const float* W, int K, int N, bf16* WT, int k0, int n0, int drow0, LAS float* scr, int lane, int perm = 0) {
#pragma unroll
    for (int i = 0; i < 32; ++i) { const int kk = 2 * i + (lane >> 5); const int k = k0 + kk, kr = perm ? ((k & ~511) | fnet_chan(k & 511)) : k;
        scr[kk * 33 + (lane & 31)] = __builtin_nontemporal_load(W + (size_t)kr * N + n0 + (lane & 31)); }
    LDS_WAIT(); asm volatile("" ::: "memory");
    const int c = lane & 7;
#pragma unroll
    for (int j = 0; j < 4; ++j) { const int n = (lane >> 3) + 8 * j; const LAS float* s = scr + (8 * c) * 33 + n;
        v4u o; o.x = pk2(s[0 * 33], s[1 * 33]); o.y = pk2(s[2 * 33], s[3 * 33]); o.z = pk2(s[4 * 33], s[5 * 33]); o.w = pk2(s[6 * 33], s[7 * 33]);
        __builtin_nontemporal_store(o, (GAS v4u*)(WT + (size_t)(drow0 + n) * K + k0 + 8 * c)); }
    LDS_WAIT(); asm volatile("" ::: "memory");
}

DI void phase_prologue(const Frame& F0, const Args& a) {
    const Frame F = launder(F0);
    unsigned char* ws = launder_ptr(a.ws);
    {
        LAS float* sv = (LAS float*)(F.lds);
        LAS float* red = (LAS float*)(F.lds + 24576);
        for (int i = F.tid; i < 3 * DM; i += 512) { const int mb = i / DM, k = i % DM; const float cv = mb < 2 ? a.c[mb * DM + k] : a.c_ctx[k]; sv[i] = cv / (1.0f + __expf(-cv)); }
        __syncthreads();
        float* mod = (float*)(ws + WS_MOD);
        for (int unit = F.vcu; unit < DEPTH * 64; unit += F.G) {
            const int li = unit >> 6, cb = unit & 63, n0 = cb * 192;
            const float* W = a.ada_w + (size_t)li * DM * NADA + n0;
            f32x4 acc0 = {0.f, 0.f, 0.f, 0.f}, acc1 = acc0, acc2 = acc0;
            if (F.lane < 48) {
                const int kb = F.wave * 256;
#pragma unroll 16
                for (int k = 0; k < 256; ++k) {
                    const f32x4 w = __builtin_nontemporal_load((const GAS f32x4*)(W + (size_t)(kb + k) * NADA + F.lane * 4));
                    const float s0 = sv[kb + k], s1 = sv[DM + kb + k], s2 = sv[2 * DM + kb + k];
                    acc0 += w * s0; acc1 += w * s1; acc2 += w * s2;
                }
                *(LAS f32x4*)(red + (F.wave * 3 + 0) * 192 + F.lane * 4) = acc0;
                *(LAS f32x4*)(red + (F.wave * 3 + 1) * 192 + F.lane * 4) = acc1;
                *(LAS f32x4*)(red + (F.wave * 3 + 2) * 192 + F.lane * 4) = acc2;
            }
            __syncthreads();
            for (int o = F.tid; o < 3 * 192; o += 512) { const int mb = o / 192, cidx = o % 192; float s = a.ada_b[(size_t)li * NADA + n0 + cidx];
#pragma unroll
                for (int w = 0; w < 8; ++w) s += red[(w * 3 + mb) * 192 + cidx];
                const int n = n0 + cidx, ch = n >> 11, col = n & (DM - 1); const float* gl = a.norm_gains + (size_t)li * 4 * DM;
                if (ch == 1) s = gl[col] * (1.0f + s); else if (ch == 2) s = gl[DM + col] * s; else if (ch == 4) s = gl[2 * DM + col] * (1.0f + s); else if (ch == 5) s = gl[3 * DM + col] * s;
                *(GAS float*)(mod + ((size_t)li * 3 + mb) * NADA + n) = s; }
            __syncthreads();
        }
    }
    {
        const int gt = F.vcu * 512 + F.tid, NT = F.G * 512;
        bf16* dftc = (bf16*)(ws + WS_DFTC); bf16* m1 = (bf16*)(ws + WS_M1); bf16* m2 = (bf16*)(ws + WS_M2); bf16* mc = (bf16*)(ws + WS_MC);
        for (int i = gt; i < 512 * 512; i += NT) { const int n = i >> 9, cidx = i & 511, part = n >> 8, m = n & 255; float s, c; sincospif(2.0f * (float)((cidx * m) & 511) / 512.0f, &s, &c);
            *(GAS bf16*)(dftc + i) = (bf16)f2bf(part == 0 ? c : (m == 0 ? ((cidx & 1) ? -1.0f : 1.0f) : -s)); }
        for (int i = gt; i < 64 * 128 * 64; i += NT) { const int n2 = i >> 13, r = (i >> 6) & 127, n1 = i & 63, qq = r >> 6, k1 = r & 63;
            float s, c; sincospif(2.0f * (float)((k1 * (64 * n1 + n2)) & 4095) / 4096.0f, &s, &c); *(GAS bf16*)(m1 + i) = (bf16)f2bf(qq ? s : c); }
        for (int i = gt; i < 64 * 128; i += NT) { const int k2 = i >> 7, cc = i & 127, pi = cc >> 6, n2 = cc & 63; float s, c; sincospif(2.0f * (float)((k2 * n2) & 63) / 64.0f, &s, &c); *(GAS bf16*)(m2 + i) = (bf16)f2bf(pi ? s : c); }
        for (int i = gt; i < 256 * 512; i += NT) { const int k = i >> 9, cc = i & 511, pi = cc >> 8, n = cc & 255; float s, c; sincospif(2.0f * (float)((k * n) & 255) / 256.0f, &s, &c); *(GAS bf16*)(mc + i) = (bf16)f2bf(pi ? s : c); }
    }
    {
        LAS float* scr = (LAS float*)(F.lds + 43008 + F.wave * 8448);
        const int gw = F.vcu * NWAVES + F.wave, NGW = F.G * NWAVES;
        constexpr int I_IN = 32 * (GIN / 32), I_SQ = 32 * 64, I_GU = 32 * (2 * DFF / 32), I_DN = (DFF / 64) * 64;
        constexpr int NITEMS = 2 * I_IN + 2 * I_SQ + 2 * I_SQ + DEPTH * I_GU + DEPTH * I_DN;
        for (int it = gw; it < NITEMS; it += NGW) {
            int r = it;
            if (r < 2 * I_IN) { const int j = r / I_IN; r %= I_IN; const int nblk = GIN / 32, kb = r / nblk, nb = r % nblk;
                transpose_item(a.gla_w_in + (size_t)j * DM * GIN, DM, GIN, (bf16*)(ws + WS_WIN) + (size_t)j * GIN_PAD * DM, 64 * kb, 32 * nb, 32 * nb, scr, F.lane); continue; }
            r -= 2 * I_IN;
            if (r < 2 * I_SQ) { const int j = r / I_SQ; r %= I_SQ; const int kb = r / 64, nb = r % 64;
                transpose_item(a.gla_w_out + (size_t)j * DM * DM, DM, DM, (bf16*)(ws + WS_WGO) + (size_t)j * DM * DM, 64 * kb, 32 * nb, 32 * nb, scr, F.lane); continue; }
            r -= 2 * I_SQ;
            if (r < 2 * I_SQ) { const int j = r / I_SQ; r %= I_SQ; const int kb = r / 64, nb = r % 64;
                transpose_item(a.fnet_w_out + (size_t)j * DM * DM, DM, DM, (bf16*)(ws + WS_WFO) + (size_t)j * DM * DM, 64 * kb, 32 * nb, 32 * nb, scr, F.lane, 1); continue; }
            r -= 2 * I_SQ;
            if (r < DEPTH * I_GU) { const int j = r / I_GU; r %= I_GU; const int nblk = 2 * DFF / 32, kb = r / nblk, nb = r % nblk, n0 = 32 * nb;
                const int jj = n0 < DFF ? n0 : n0 - DFF; const int drow = (jj >> 7) * 256 + (n0 < DFF ? 0 : 128) + (jj & 127);
                transpose_item(a.ffn_w_gu + (size_t)j * DM * 2 * DFF, DM, 2 * DFF, (bf16*)(ws + WS_WGU) + (size_t)j * 2 * DFF * DM, 64 * kb, n0, drow, scr, F.lane); continue; }
            r -= DEPTH * I_GU;
            { const int j = r / I_DN; r %= I_DN; const int kb = r / 64, nb = r % 64;
                transpose_item(a.ffn_w_down + (size_t)j * DFF * DM, DFF, DM, (bf16*)(ws + WS_WDN) + (size_t)j * DM * DFF, 64 * kb, 32 * nb, 32 * nb, scr, F.lane); }
        }
    }
}

DI void norm_load_x(f32x4 (&v)[8], const void* xlat, const void* xctx, int xin_bf16, int R, int co) {
    if (xin_bf16) { const bf16* xr = R < NLAT ? (const bf16*)xlat + (size_t)R * DM : (const bf16*)xctx + (size_t)(R - NLAT) * DM;
        v2u t[8];
#pragma unroll
        for (int j = 0; j < 8; ++j) t[j] = *(const GAS v2u*)(xr + j * 256 + co);
#pragma unroll
        for (int j = 0; j < 8; ++j) v[j] = (f32x4){bflo(t[j].x), bfhi(t[j].x), bflo(t[j].y), bfhi(t[j].y)}; }
    else { const float* xr = R < NLAT ? (const float*)xlat + (size_t)R * DM : (const float*)xctx + (size_t)(R - NLAT) * DM;
#pragma unroll
        for (int j = 0; j < 8; ++j) v[j] = *(const GAS f32x4*)(xr + j * 256 + co); }
}
DI void phase_norm(const Frame& F0, int nrows, const void* xlat, const void* xctx, int xin_bf16, const bf16* Y, const float* gainY, const float* gate  ,
                   void* Xout_lat, void* Xout_ctx, int xout_bf16, bf16* Hout, const float* gainH, const float* shift, const float* scale) {
    const Frame F = launder(F0);
    const int gw = F.vcu * NWAVES + F.wave, NGW = F.G * NWAVES;
    const int co = F.lane * 4;
    const int nfull = nrows / NGW, xr = F.wave * F.G + F.vcu, nit = nfull + (xr < nrows - nfull * NGW ? 1 : 0);
#define NORM_ROW(i) ((i) < nfull ? gw + (i) * NGW : nfull * NGW + xr)
    f32x4 v[8]; v2u yb[8];
    if (nit > 0) { const int R0 = NORM_ROW(0); norm_load_x(v, xlat, xctx, xin_bf16, R0, co);
        if (Y) {
#pragma unroll
            for (int j = 0; j < 8; ++j) yb[j] = *(const GAS v2u*)(Y + (size_t)R0 * DM + j * 256 + co); } }
    f32x4 gt[8], sh[8], sc[8]; int mbp = -1;
    for (int it = 0; it < nit; ++it) {
        const int R = NORM_ROW(it); const int mb = row_mb(R), Rn = NORM_ROW(it + 1);
        f32x4 vn[8]; v2u ybn[8];
        if (it + 1 < nit) { norm_load_x(vn, xlat, xctx, xin_bf16, Rn, co);
            if (Y) {
#pragma unroll
                for (int j = 0; j < 8; ++j) ybn[j] = *(const GAS v2u*)(Y + (size_t)Rn * DM + j * 256 + co); } }
        if (mb != mbp) { mbp = mb;
            if (Y) {
#pragma unroll
                for (int j = 0; j < 8; ++j) gt[j] = *(const GAS f32x4*)(gate + (size_t)mb * NADA + j * 256 + co); }
            if (Hout) {
#pragma unroll
                for (int j = 0; j < 8; ++j) { sh[j] = *(const GAS f32x4*)(shift + (size_t)mb * NADA + j * 256 + co); sc[j] = *(const GAS f32x4*)(scale + (size_t)mb * NADA + j * 256 + co); } } }
        if (Y) {
            f32x4 y[8]; float ss = 0.f;
#pragma unroll
            for (int j = 0; j < 8; ++j) { y[j] = (f32x4){bflo(yb[j].x), bfhi(yb[j].x), bflo(yb[j].y), bfhi(yb[j].y)};
                ss += (y[j].x * y[j].x + y[j].y * y[j].y) + (y[j].z * y[j].z + y[j].w * y[j].w); }
            const float rs = __builtin_amdgcn_rsqf(wave_sum(ss) * (1.0f / DM) + EPS);
#pragma unroll
            for (int j = 0; j < 8; ++j) v[j] = v[j] + gt[j] * (y[j] * rs);
        }
        if (Xout_lat) {
            if (xout_bf16) { bf16* xo = R < NLAT ? (bf16*)Xout_lat + (size_t)R * DM : (bf16*)Xout_ctx + (size_t)(R - NLAT) * DM;
#pragma unroll
                for (int j = 0; j < 8; ++j) { v2u o; o.x = pk2(v[j].x, v[j].y); o.y = pk2(v[j].z, v[j].w); *(GAS v2u*)(xo + j * 256 + co) = o; } }
            else { float* xo = R < NLAT ? (float*)Xout_lat + (size_t)R * DM : (float*)Xout_ctx + (size_t)(R - NLAT) * DM;
#pragma unroll
                for (int j = 0; j < 8; ++j) *(GAS f32x4*)(xo + j * 256 + co) = v[j]; } }
        if (Hout) {
            float ss = 0.f;
#pragma unroll
            for (int j = 0; j < 8; ++j) ss += (v[j].x * v[j].x + v[j].y * v[j].y) + (v[j].z * v[j].z + v[j].w * v[j].w);
            const float rs = __builtin_amdgcn_rsqf(wave_sum(ss) * (1.0f / DM) + EPS);
            v2u o[8];
#pragma unroll
            for (int j = 0; j < 8; ++j) { const f32x4 h = (v[j] * rs) * sc[j] + sh[j]; o[j].x = pk2(h.x, h.y); o[j].y = pk2(h.z, h.w); }
#pragma unroll
            for (int j = 0; j < 8; ++j) *(GAS v2u*)(Hout + (size_t)R * DM + j * 256 + co) = o[j];
        }
#pragma unroll
        for (int j = 0; j < 8; ++j) { v[j] = vn[j]; yb[j] = ybn[j]; }
    }
#undef NORM_ROW
}

DI int chunk_row(int b, int ci, int c, int colmajor) {
    if (ci < 4) return NLAT + b * CTXL + ci * 64 + c;
    const int n = ci - 4; const int tok = colmajor ? (c * 64 + n) : (n * 64 + c);
    return b * SEQ + tok;
}
DI float log_sigmoid_f(float x) { return fminf(x, 0.f) - log1pf(__expf(-fabsf(x))); }

DI void phase_lr(const Frame& F0, const Args& a, int jl) {
    const Frame F = launder(F0);
    unsigned char* ws = launder_ptr(a.ws); const bf16* Hb = (const bf16*)(ws + WS_H); const bf16* Wl = (const bf16*)(ws + WS_WIN) + ((size_t)jl * GIN_PAD + 6144) * DM; float* LR = (float*)(ws + WS_LR);
    LAS f32x4* red = (LAS f32x4*)F.lds;
    const int l15 = F.lane & 15, l4 = F.lane >> 4;
    for (int unit = (int)blockIdx.x; unit < MROWS / 64; unit += F.G) {
        const int r0 = unit * 64; f32x4 acc[4][2];
#pragma unroll
        for (int x = 0; x < 4; ++x)
#pragma unroll
            for (int y = 0; y < 2; ++y) acc[x][y] = (f32x4){0.f, 0.f, 0.f, 0.f};
#pragma unroll
        for (int ks = 0; ks < 8; ++ks) { const int k = F.wave * 256 + ks * 32 + 8 * l4;
            const bf16x8 b0 = ld_frag_g(Wl + (size_t)l15 * DM + k), b1 = ld_frag_g(Wl + (size_t)(16 + l15) * DM + k);
#pragma unroll
            for (int x = 0; x < 4; ++x) { const bf16x8 af = ld_frag_g(Hb + (size_t)(r0 + x * 16 + l15) * DM + k); acc[x][0] = mfma16(af, b0, acc[x][0]); acc[x][1] = mfma16(af, b1, acc[x][1]); } }
#pragma unroll
        for (int x = 0; x < 4; ++x)
#pragma unroll
            for (int y = 0; y < 2; ++y) red[(F.wave * 8 + x * 2 + y) * 64 + F.lane] = acc[x][y];
        __syncthreads();
        { const int t = F.wave; f32x4 s = red[t * 64 + F.lane];
#pragma unroll
            for (int w = 1; w < 8; ++w) s += red[(w * 8 + t) * 64 + F.lane];
            const int x = t >> 1, y = t & 1;
#pragma unroll
            for (int r = 0; r < 4; ++r) LR[(size_t)(r0 + x * 16 + 4 * l4 + r) * 32 + y * 16 + l15] = s[r]; }
        __syncthreads();
    }
}

DI int cp_swz(int row, int k) { return row * 512 + ((((k >> 3) ^ (row & 15)) << 4) | ((k & 7) << 1)); }
DI void phase_chunk_prep(const Frame& F0, const Args& a, int jl, int colmajor) {
    const Frame Fo = launder(F0);
    for (int unit = (int)blockIdx.x; unit < NCG * NH; unit += Fo.G) {
    const Frame F = launder(Fo);
    unsigned char* ws = launder_ptr(a.ws);
    const bf16* Qb = (const bf16*)(ws + WS_Q); const bf16* Kb = (const bf16*)(ws + WS_K); const bf16* Vb = (const bf16*)(ws + WS_V); const float* LR = (const float*)(ws + WS_LR);
    bf16* QD = (bf16*)(ws + WS_QD); bf16* KET = (bf16*)(ws + WS_KET); bf16* VT = (bf16*)(ws + WS_VT); bf16* AM = (bf16*)(ws + WS_AM); float* DEC = (float*)(ws + WS_DEC);
    LAS float* lf = (LAS float*)(F.lds + 136192);
    const int dir = F.tid >> 8, k = F.tid & 255, ww = F.wave & 3;
    LAS unsigned char* qd_l = F.lds + dir * 32768;
    LAS unsigned char* ki_l = F.lds + 65536 + dir * 32768;
    {
        const int cg = unit >> 2, h = unit & 3, b = cg / NCHUNK, ci = cg % NCHUNK;
#pragma unroll
        for (int i = 0; i < 8; ++i) { const int r = (ww * 8 + i) * 2 + (F.lane >> 5), lc = (F.lane & 31) ^ (r & 15); const int R = chunk_row(b, ci, r, colmajor);
            __builtin_amdgcn_global_load_lds((const unsigned*)(Qb + (size_t)R * KD + h * HK + lc * 8), (LAS unsigned*)(qd_l + (ww * 8 + i) * 1024), 16, 0, 0);
            __builtin_amdgcn_global_load_lds((const unsigned*)(Kb + (size_t)R * KD + h * HK + lc * 8), (LAS unsigned*)(ki_l + (ww * 8 + i) * 1024), 16, 0, 0); }
        { const int c = F.tid >> 3, r4 = (F.tid & 7) * 4; const int R = chunk_row(b, ci, c, colmajor);
          *(LAS f32x4*)(lf + c * 32 + r4) = *(const GAS f32x4*)(LR + (size_t)R * 32 + r4); }
        const float* wg2 = dir ? a.gla_wg2_b : a.gla_wg2_f; const float* bg = dir ? a.gla_bg_b : a.gla_bg_f;
        const float bias = *(const GAS float*)(bg + (size_t)jl * KD + h * HK + k);
        const int hh = F.lane >> 5, li = F.lane & 31;
        bf16x8 Bf[2];
#pragma unroll
        for (int j = 0; j < 2; ++j) { float wv[8];
#pragma unroll
            for (int jj = 0; jj < 8; ++jj) wv[jj] = *(const GAS float*)(wg2 + ((size_t)jl * GR + 8 * hh + jj) * KD + h * HK + (F.wave & 3) * 64 + 32 * j + li);
            const v4u pkw = (v4u){pk2(wv[0], wv[1]), pk2(wv[2], wv[3]), pk2(wv[4], wv[5]), pk2(wv[6], wv[7])}; Bf[j] = __builtin_bit_cast(bf16x8, pkw); }
        VM_WAIT(); __syncthreads();
        float cum[64];
        { typedef float f32x16 __attribute__((ext_vector_type(16)));
          f32x16 z; for (int i = 0; i < 16; ++i) z[i] = 0.f;
#pragma unroll
          for (int t = 0; t < 2; ++t) {
              bf16x8 Af[2];
#pragma unroll
              for (int x = 0; x < 2; ++x) { const LAS f32x4* l = (const LAS f32x4*)(lf + (32 * t + (li ^ (4 * x))) * 32 + dir * 16 + 8 * hh);
                  const f32x4 a0 = l[0], a1 = l[1];
                  const v4u pka = (v4u){pk2(a0.x, a0.y), pk2(a0.z, a0.w), pk2(a1.x, a1.y), pk2(a1.z, a1.w)}; Af[x] = __builtin_bit_cast(bf16x8, pka); }
#pragma unroll
              for (int v = 0; v < 4; ++v) { const int hi_rows = v >> 1, upper = v & 1;
                  const f32x16 P = __builtin_amdgcn_mfma_f32_32x32x16_bf16(Af[hi_rows ^ upper], Bf[upper], z, 0, 0, 0);
#pragma unroll
                  for (int r = 0; r < 16; ++r) { const int c = 32 * t + 8 * (r >> 2) + 4 * hi_rows + (r & 3); cum[c] = upper ? (hh ? P[r] : cum[c]) : P[r]; }
                  __builtin_amdgcn_sched_barrier(0); }
          }
        }
#pragma unroll
        for (int c = 0; c < 64; ++c) { const float s = cum[c] + bias;
            cum[c] = fminf(s, 0.f) * (1.0f / 16.0f) - __builtin_amdgcn_logf(1.0f + __builtin_amdgcn_exp2f(-1.44269504f * fabsf(s))) * (0.69314718f / 16.0f); }
        if (dir == 0) {
#pragma unroll
            for (int c = 1; c < 64; ++c) cum[c] += cum[c - 1];
        } else {
#pragma unroll
            for (int c = 62; c >= 0; --c) cum[c] += cum[c + 1];
        }
        const float last = dir == 0 ? cum[63] : cum[0]; const float elast = __expf(last);
        *(GAS float*)(DEC + (((size_t)dir * NCG + cg) * NH + h) * HK + k) = elast;
        unsigned kep[32];
#pragma unroll
        for (int cb = 0; cb < 64; cb += 16) {
            unsigned short qr[16], kr[16];
#pragma unroll
            for (int u = 0; u < 16; ++u) { const int off = cp_swz(cb + u, k); qr[u] = *(const LAS unsigned short*)(qd_l + off); kr[u] = *(const LAS unsigned short*)(ki_l + off); }
#pragma unroll
            for (int u2 = 0; u2 < 8; ++u2) { float ke2[2];
#pragma unroll
                for (int u = 0; u < 2; ++u) { const int c = cb + 2 * u2 + u; const int off = cp_swz(c, k);
                    const float q = bf2f(qr[2 * u2 + u]), kk = bf2f(kr[2 * u2 + u]);
                    const float ec = __expf(cum[c]); const float qd = q * ec, kinv = kk * __builtin_amdgcn_rcpf(ec); ke2[u] = kinv * elast;
                    const unsigned qk = pk2(qd, kinv);
                    *(GAS unsigned short*)(QD + ((((size_t)dir * NCG + cg) * NH + h) * 64 + c) * HK + k) = (unsigned short)qk;
                    *(LAS unsigned short*)(qd_l + off) = (unsigned short)qk;
                    *(LAS unsigned short*)(ki_l + off) = (unsigned short)(qk >> 16); }
                kep[(cb >> 1) + u2] = pk2(ke2[0], ke2[1]); } }
        { GAS v4u* dst = (GAS v4u*)(KET + ((((size_t)dir * NCG + cg) * NH + h) * HK + k) * 64);
#pragma unroll
          for (int q = 0; q < 8; ++q) dst[q] = (v4u){kep[4 * q], kep[4 * q + 1], kep[4 * q + 2], kep[4 * q + 3]}; }
        __syncthreads();
#pragma unroll
        for (int tt = 0; tt < 4; ++tt) { const int t = 4 * F.wave + tt, d = t >> 4, jt = (t >> 2) & 3, it = t & 3; f32x4 acc = {0.f, 0.f, 0.f, 0.f};
            const int rj = jt * 16 + (F.lane & 15), ri = it * 16 + (F.lane & 15);
            const LAS unsigned char* kb = F.lds + 65536 + d * 32768 + rj * 512; const LAS unsigned char* qb = F.lds + d * 32768 + ri * 512;
#pragma unroll
            for (int kk = 0; kk < 8; ++kk) { const int ch = kk * 4 + (F.lane >> 4);
                acc = mfma16(ld_frag_l(kb + ((ch ^ (rj & 15)) << 4)), ld_frag_l(qb + ((ch ^ (ri & 15)) << 4)), acc); }
            const int i = ri, j0 = jt * 16 + 4 * (F.lane >> 4); float o[4];
#pragma unroll
            for (int r = 0; r < 4; ++r) { const int j = j0 + r; const bool keep = d == 0 ? (j <= i) : (j >= i); o[r] = keep ? acc[r] : 0.f; }
            v2u pkd; pkd.x = pk2(o[0], o[1]); pkd.y = pk2(o[2], o[3]);
            *(GAS v2u*)(AM + ((((size_t)d * NCG + cg) * NH + h) * 64 + i) * 64 + j0) = pkd; }
        __syncthreads();
    }
    }
}

constexpr int SC_QD = 0, SC_KE = 33792, SC_VT = 70656, SC_AM = 79872, SC_ST = 89088;
struct ScanFr { v4u q[4], ke[4], vt, am, dq; };
constexpr int SC_DEC = 122880;
constexpr int SC_ST1 = 123904;
DI int scan_ci(int s, int dir) { return dir == 0 ? s : (s < 4 ? 3 - s : 4 + (63 - (s - 4))); }
struct ScanCtx { const bf16 *QD, *KET, *V, *AM; const float* DEC; bf16* O; LAS unsigned char* L; int b, h, dir, sl, tid, w, l15, l4, lane, colmajor; unsigned oq0, oq1, oq2, oq3, oqc0, oqc1, oqc2, oqc3, oo0, oo1, ooc0, ooc1, ov, ovc; };
DI int scan_rowbase(const ScanCtx& c, int ci) { return ci < 4 ? NLAT + c.b * CTXL + ci * 64 : (c.colmajor ? c.b * SEQ + (ci - 4) : c.b * SEQ + (ci - 4) * 64); }
DI void scan_load(ScanFr& f, int s, const ScanCtx& c) {
    s = s < NCHUNK ? s : NCHUNK - 1;
    const int ci = scan_ci(s, c.dir), cg = c.b * NCHUNK + ci; const bool lin = ci < 4 || !c.colmajor;
    const char* qb = (const char*)c.QD + (((size_t)c.dir * NCG + cg) * NH + c.h) * 64 * HK * 2 + c.tid * 16;
#pragma unroll
    for (int i = 0; i < 4; ++i) f.q[i] = *(const GAS v4u*)(qb + i * 8192);
    const char* kb = (const char*)c.KET + (((size_t)c.dir * NCG + cg) * NH + c.h) * HK * 64 * 2 + c.tid * 16;
#pragma unroll
    for (int i = 0; i < 4; ++i) f.ke[i] = *(const GAS v4u*)(kb + i * 8192);
    f.vt = *(const GAS v4u*)((const char*)c.V + (size_t)scan_rowbase(c, ci) * VD * 2 + (lin ? c.ov : c.ovc));
    f.am = *(const GAS v4u*)((const char*)c.AM + (((size_t)c.dir * NCG + cg) * NH + c.h) * 64 * 64 * 2 + c.tid * 16);
    f.dq = *(const GAS v4u*)((const char*)c.DEC + (((size_t)c.dir * NCG + cg) * NH + c.h) * HK * 4 + (c.tid & 63) * 16);
}
template <int PAR> DI void scan_step64(ScanFr& f, f32x4 (&S)[2][4], int s, const ScanCtx& c) {
    LAS unsigned char* L = c.L; const int tid = c.tid, w = c.w, l15 = c.l15, l4 = c.l4;
    const int ci = scan_ci(s, c.dir);
#pragma unroll
    for (int i = 0; i < 4; ++i) { const int p = tid + 512 * i; *(LAS v4u*)(L + SC_QD + (p >> 5) * 528 + (p & 31) * 16) = f.q[i]; *(LAS v4u*)(L + SC_KE + (p >> 3) * 144 + (p & 7) * 16) = f.ke[i]; }
    *(LAS v4u*)(L + SC_VT + (tid >> 3) * 144 + (tid & 7) * 16) = f.vt; *(LAS v4u*)(L + SC_AM + (tid >> 3) * 144 + (tid & 7) * 16) = f.am;
    if (tid < 64) *(LAS v4u*)(L + SC_DEC + tid * 16) = f.dq;
    __syncthreads();
    const f32x4 dec0 = *(const LAS f32x4*)(L + SC_DEC + ((2 * w) * 16 + 4 * l4) * 4), dec1 = *(const LAS f32x4*)(L + SC_DEC + ((2 * w + 1) * 16 + 4 * l4) * 4);
    scan_load(f, s + 2, c);
#define SC_VFR(e0, c0) __builtin_shufflevector(vtr(L + SC_VT + ((c0) + 8 * l4 + (l15 >> 2)) * 144 + ((e0) + 4 * (l15 & 3)) * 2), vtr(L + SC_VT + ((c0) + 8 * l4 + (l15 >> 2) + 4) * 144 + ((e0) + 4 * (l15 & 3)) * 2), 0, 1, 2, 3, 4, 5, 6, 7)
    bf16x8 kf[2][2];
#pragma unroll
    for (int x = 0; x < 2; ++x)
#pragma unroll
        for (int cc = 0; cc < 2; ++cc) kf[x][cc] = ld_frag_l(L + SC_KE + ((2 * w + x) * 16 + l15) * 144 + (cc * 32 + 8 * l4) * 2);
    const int et = w & 3, ct0 = 2 * (w >> 2);
    {
        bf16x8 va[2], vb[2];
#pragma unroll
        for (int cc = 0; cc < 2; ++cc) va[cc] = SC_VFR(0 * 16, cc * 32);
#pragma unroll
        for (int y = 0; y < 4; y += 2) {
#pragma unroll
            for (int cc = 0; cc < 2; ++cc) vb[cc] = SC_VFR((y + 1) * 16, cc * 32);
#pragma unroll
            for (int x = 0; x < 2; ++x) { f32x4 acc = S[x][y] * (x ? dec1 : dec0);
#pragma unroll
                for (int cc = 0; cc < 2; ++cc) acc = mfma16(kf[x][cc], va[cc], acc);
                S[x][y] = acc; }
            if (y + 2 < 4) {
#pragma unroll
                for (int cc = 0; cc < 2; ++cc) va[cc] = SC_VFR((y + 2) * 16, cc * 32); }
#pragma unroll
            for (int x = 0; x < 2; ++x) { f32x4 acc = S[x][y + 1] * (x ? dec1 : dec0);
#pragma unroll
                for (int cc = 0; cc < 2; ++cc) acc = mfma16(kf[x][cc], vb[cc], acc);
                S[x][y + 1] = acc; }
        }
    }
#pragma unroll
    for (int x = 0; x < 2; ++x)
#pragma unroll
        for (int y = 0; y < 4; ++y) { const int kk = (2 * w + x) * 16 + 4 * l4, e = y * 16 + l15; v2u p; p.x = pk2(S[x][y][0], S[x][y][1]); p.y = pk2(S[x][y][2], S[x][y][3]);
            *(LAS v2u*)(L + (PAR ? SC_ST : SC_ST1) + e * 528 + kk * 2) = p; }
    const bool lin = ci < 4 || !c.colmajor;
    char* ob = (char*)c.O + ((size_t)c.dir * MROWS + scan_rowbase(c, ci)) * VD * 2;
    f32x4 o0 = {0.f, 0.f, 0.f, 0.f}, o1 = o0;
    bf16x8 A0, B00, B01, A1, B10, B11;
#define SC_OFR(i, A, Ba, Bb) do { if ((i) < 2) { A = SC_VFR(et * 16, (i) * 32); Ba = ld_frag_l(L + SC_AM + (ct0 * 16 + l15) * 144 + ((i) * 32 + 8 * l4) * 2); Bb = ld_frag_l(L + SC_AM + ((ct0 + 1) * 16 + l15) * 144 + ((i) * 32 + 8 * l4) * 2); } \
        else { A = ld_frag_l(L + (PAR ? SC_ST1 : SC_ST) + (et * 16 + l15) * 528 + (((i) - 2) * 32 + 8 * l4) * 2); Ba = ld_frag_l(L + SC_QD + (ct0 * 16 + l15) * 528 + (((i) - 2) * 32 + 8 * l4) * 2); Bb = ld_frag_l(L + SC_QD + ((ct0 + 1) * 16 + l15) * 528 + (((i) - 2) * 32 + 8 * l4) * 2); } } while (0)
    SC_OFR(0, A0, B00, B01);
#pragma unroll
    for (int i = 0; i < 10; i += 2) {
        SC_OFR(i + 1, A1, B10, B11);
        o0 = mfma16(A0, B00, o0); o1 = mfma16(A0, B01, o1);
        if (i + 2 < 10) SC_OFR(i + 2, A0, B00, B01);
        o0 = mfma16(A1, B10, o0); o1 = mfma16(A1, B11, o1);
    }
#undef SC_OFR
#undef SC_VFR
    { v2u p; p.x = pk2(o0[0], o0[1]); p.y = pk2(o0[2], o0[3]); *(GAS v2u*)(ob + (lin ? c.oo0 : c.ooc0)) = p;
      v2u q; q.x = pk2(o1[0], o1[1]); q.y = pk2(o1[2], o1[3]); *(GAS v2u*)(ob + (lin ? c.oo1 : c.ooc1)) = q; }
    __syncthreads();
}
DI void phase_scan(const Frame& F0, const Args& a, int colmajor) {
    const Frame F = launder(F0);
    unsigned char* ws = launder_ptr(a.ws);
    ScanCtx c; c.QD = (const bf16*)(ws + WS_QD); c.KET = (const bf16*)(ws + WS_KET); c.V = (const bf16*)(ws + WS_V); c.AM = (const bf16*)(ws + WS_AM); c.DEC = (const float*)(ws + WS_DEC);
    c.O = (bf16*)(ws + WS_O); c.L = F.lds; c.tid = F.tid; c.w = F.wave; c.lane = F.lane; c.l15 = F.lane & 15; c.l4 = F.lane >> 4; c.colmajor = colmajor;
    for (int it = F.vcu; it < 256; it += F.G) {
        if ((it & 31) >= 16) continue;
        const int item = (it >> 5) * 16 + (it & 15), bhd = item >> 3;
        c.sl = item & 7; c.b = bhd >> 3; c.h = (bhd >> 1) & 3; c.dir = bhd & 1;
#define SC_OQ(i, lin_) (unsigned)(((((c.tid + 512 * (i)) >> 5) * ((lin_) ? 1 : 64)) * KD + c.h * HK + ((c.tid + 512 * (i)) & 31) * 8) * 2)
        c.oq0 = SC_OQ(0, 1); c.oq1 = SC_OQ(1, 1); c.oq2 = SC_OQ(2, 1); c.oq3 = SC_OQ(3, 1); c.oqc0 = SC_OQ(0, 0); c.oqc1 = SC_OQ(1, 0); c.oqc2 = SC_OQ(2, 0); c.oqc3 = SC_OQ(3, 0);
#undef SC_OQ
#define SC_OO(t, lin_) (unsigned)(((((2 * (c.w >> 2) + (t)) * 16 + c.l15) * ((lin_) ? 1 : 64)) * VD + c.h * HV + c.sl * 64 + (c.w & 3) * 16 + 4 * c.l4) * 2)
        c.oo0 = SC_OO(0, 1); c.oo1 = SC_OO(1, 1); c.ooc0 = SC_OO(0, 0); c.ooc1 = SC_OO(1, 0);
        c.ov = (unsigned)(((c.tid >> 3) * VD + c.h * HV + c.sl * 64 + (c.tid & 7) * 8) * 2); c.ovc = (unsigned)(((c.tid >> 3) * 64 * VD + c.h * HV + c.sl * 64 + (c.tid & 7) * 8) * 2);
#undef SC_OO
        f32x4 S[2][4];
#pragma unroll
        for (int x = 0; x < 2; ++x)
#pragma unroll
            for (int y = 0; y < 4; ++y) S[x][y] = (f32x4){0.f, 0.f, 0.f, 0.f};
        ScanFr fa, fb;
        scan_load(fa, 0, c); scan_load(fb, 1, c);
#pragma unroll
        for (int x = 0; x < 2; ++x)
#pragma unroll
            for (int y = 0; y < 4; ++y) *(LAS v2u*)(c.L + SC_ST + (y * 16 + c.l15) * 528 + ((2 * c.w + x) * 16 + 4 * c.l4) * 2) = (v2u){0u, 0u};
        for (int s = 0; s < NCHUNK; s += 2) { scan_step64<0>(fa, S, s, c); scan_step64<1>(fb, S, s + 1, c); }
    }
}

DI void phase_gla_post(const Frame& F0, const Args& a, int jl, int nrows) {
    const Frame F = launder(F0);
    unsigned char* ws = launder_ptr(a.ws);
    const bf16* O = (const bf16*)(ws + WS_O); const bf16* Rb = (const bf16*)(ws + WS_R); bf16* U = (bf16*)(ws + WS_H);
    const int gw = F.vcu * NWAVES + F.wave, NGW = F.G * NWAVES;
    const f32x4 g0 = *(const GAS f32x4*)(a.gla_head_gain + (size_t)jl * HV + F.lane * 8), g1 = *(const GAS f32x4*)(a.gla_head_gain + (size_t)jl * HV + F.lane * 8 + 4);
    v4u of[4], ob[4], rr[4];
    const int nfull = nrows / NGW, xr = F.wave * F.G + F.vcu, nit = nfull + (xr < nrows - nfull * NGW ? 1 : 0);
#define POST_ROW(i) ((i) < nfull ? gw + (i) * NGW : nfull * NGW + xr)
    if (nit > 0) { const int R0 = POST_ROW(0);
#pragma unroll
        for (int j = 0; j < 4; ++j) { const size_t off = (size_t)R0 * VD + j * HV + F.lane * 8;
            of[j] = *(const GAS v4u*)(O + off); ob[j] = *(const GAS v4u*)(O + (size_t)MROWS * VD + off); rr[j] = *(const GAS v4u*)(Rb + off); } }
    for (int it = 0; it < nit; ++it) { const int R = POST_ROW(it);
        v4u ofn[4], obn[4], rrn[4]; const int Rn = POST_ROW(it + 1);
        if (it + 1 < nit) {
#pragma unroll
            for (int j = 0; j < 4; ++j) { const size_t off = (size_t)Rn * VD + j * HV + F.lane * 8;
                ofn[j] = *(const GAS v4u*)(O + off); obn[j] = *(const GAS v4u*)(O + (size_t)MROWS * VD + off); rrn[j] = *(const GAS v4u*)(Rb + off); } }
        v4u wout[4];
#pragma unroll
        for (int j = 0; j < 4; ++j) {
            float o[8], r[8];
#pragma unroll
            for (int q = 0; q < 4; ++q) { o[2 * q] = bflo(of[j][q]) + bflo(ob[j][q]); o[2 * q + 1] = bfhi(of[j][q]) + bfhi(ob[j][q]); r[2 * q] = bflo(rr[j][q]); r[2 * q + 1] = bfhi(rr[j][q]); }
            float ss = 0.f;
#pragma unroll
            for (int q = 0; q < 8; ++q) ss += o[q] * o[q];
            const float rs = __builtin_amdgcn_rsqf(wave_sum(ss) * (1.0f / HV) + EPS);
            float u[8];
#pragma unroll
            for (int q = 0; q < 8; ++q) { const float g = q < 4 ? g0[q] : g1[q - 4]; u[q] = o[q] * rs * g * silu_f(r[q]); }
            wout[j] = (v4u){pk2(u[0], u[1]), pk2(u[2], u[3]), pk2(u[4], u[5]), pk2(u[6], u[7])};
        }
#pragma unroll
        for (int j = 0; j < 4; ++j) *(GAS v4u*)(U + (size_t)R * VD + j * HV + F.lane * 8) = wout[j];
#pragma unroll
        for (int j = 0; j < 4; ++j) { of[j] = ofn[j]; ob[j] = obn[j]; rr[j] = rrn[j]; }
    }
#undef POST_ROW
}

template <int NK, int NM, class RowIn, class Store>
DI void dft_unit(const Frame& F, const RowIn& rin, const bf16* Mx  , const Store& st) {
    LAS unsigned char* D = F.lds;
    constexpr int PIECES = NK * 8;
    for (int p = F.tid; p < PIECES; p += 512) { const int row = p >> 3, ch = p & 7; *(LAS v4u*)(D + row * 144 + ch * 16) = *(const GAS v4u*)(rin(row) + ch * 8); }
    __syncthreads();
    const int l15 = F.lane & 15, l4 = F.lane >> 4, q = l15 >> 2, pp = l15 & 3;
    constexpr int TPW = NM / 32;
#pragma unroll
    for (int i = 0; i < TPW; ++i) { const int t = F.wave * TPW + i, mt = t >> 2, ct = t & 3; f32x4 acc = {0.f, 0.f, 0.f, 0.f};
#pragma unroll 4
        for (int kk = 0; kk < NK / 32; ++kk) {
            const LAS unsigned char* ad = D + (kk * 32 + 8 * l4 + q) * 144 + (ct * 16 + 4 * pp) * 2;
            const s16x4 lo = vtr(ad), hi = vtr(ad + 4 * 144);
            const bf16x8 af = __builtin_shufflevector(lo, hi, 0, 1, 2, 3, 4, 5, 6, 7);
            const bf16x8 bfr = ld_frag_g(Mx + (size_t)(mt * 16 + l15) * NK + kk * 32 + 8 * l4);
            acc = mfma16(af, bfr, acc); }
        st(mt * 16 + l15, ct * 16 + 4 * l4, acc); }
    __syncthreads();
}
struct RowInS1 { const bf16* base; DI const bf16* operator()(int row) const { const int pi = row >> 6, n1 = row & 63; return base + (size_t)(64 * n1) * 4096 + pi * 512; } };
struct StoreS1 { bf16* base; DI void operator()(int m, int ch, const f32x4& v) const { const int po = m >> 6, k1 = m & 63; v2u p; p.x = pk2(v[0], v[1]); p.y = pk2(v[2], v[3]);
    *(GAS v2u*)(base + (size_t)(k1 * 64) * 4096 + po * 512 + ch) = p; } };
struct RowInS2 { const bf16* base; DI const bf16* operator()(int row) const { const int pi = row >> 6, n2 = row & 63; return base + (size_t)n2 * 4096 + pi * 512; } };
struct StoreS2 { bf16* base; float sc; DI void operator()(int m, int ch, const f32x4& v) const { v2u p; p.x = pk2(v[0] * sc, v[1] * sc); p.y = pk2(v[2] * sc, v[3] * sc);
    *(GAS v2u*)(base + (size_t)(64 * m) * DM + ch) = p; } };
struct RowInC { const bf16* base; DI const bf16* operator()(int row) const { const int pi = row >> 8, n = row & 255; return base + (size_t)n * 4096 + pi * 512; } };
struct StoreC { bf16* base; float sc; DI void operator()(int m, int ch, const f32x4& v) const { v2u p; p.x = pk2(v[0] * sc, v[1] * sc); p.y = pk2(v[2] * sc, v[3] * sc);
    *(GAS v2u*)(base + (size_t)m * DM + ch) = p; } };

template <int NM, class Spec, int NU = 16>
DI void dft_pipe16(const Frame& F, const Spec& spec, int u0, const bf16* Mx) {
    constexpr int NK = 128, TPW = NM / 32, TILE = NK * 144;
    const int l15 = F.lane & 15, l4 = F.lane >> 4, q = l15 >> 2, pp = l15 & 3;
    const int mt = (F.wave * TPW) >> 2;
    bf16x8 mx[4];
#pragma unroll
    for (int kk = 0; kk < 4; ++kk) mx[kk] = ld_frag_g(Mx + (size_t)(mt * 16 + l15) * NK + kk * 32 + 8 * l4);
    v4u pre[2];
    { const auto ri = spec.rin(u0);
#pragma unroll
      for (int i = 0; i < 2; ++i) { const int p = F.tid + 512 * i; pre[i] = *(const GAS v4u*)(ri(p >> 3) + (p & 7) * 8); } }
#pragma unroll
    for (int i = 0; i < 2; ++i) { const int p = F.tid + 512 * i; *(LAS v4u*)(F.lds + (p >> 3) * 144 + (p & 7) * 16) = pre[i]; }
    __syncthreads();
    for (int k = 0; k < NU; ++k) {
        LAS unsigned char* D = F.lds + (k & 1) * TILE;
        if (k + 1 < NU) { const auto ri = spec.rin(u0 + k + 1);
#pragma unroll
            for (int i = 0; i < 2; ++i) { const int p = F.tid + 512 * i; pre[i] = *(const GAS v4u*)(ri(p >> 3) + (p & 7) * 8); } }
        const auto st = spec.sto(u0 + k);
#pragma unroll
        for (int i = 0; i < TPW; ++i) { const int ct = (F.wave * TPW + i) & 3; f32x4 acc = {0.f, 0.f, 0.f, 0.f};
#pragma unroll
            for (int kk = 0; kk < 4; ++kk) {
                const LAS unsigned char* ad = D + (kk * 32 + 8 * l4 + q) * 144 + (ct * 16 + 4 * pp) * 2;
                const s16x4 lo = vtr(ad), hi = vtr(ad + 4 * 144);
                acc = mfma16(__builtin_shufflevector(lo, hi, 0, 1, 2, 3, 4, 5, 6, 7), mx[kk], acc); }
            st(mt * 16 + l15, ct * 16 + 4 * l4, acc); }
        if (k + 1 < NU) { LAS unsigned char* Dn = F.lds + ((k + 1) & 1) * TILE;
#pragma unroll
            for (int i = 0; i < 2; ++i) { const int p = F.tid + 512 * i; *(LAS v4u*)(Dn + (p >> 3) * 144 + (p & 7) * 16) = pre[i]; } }
        __syncthreads();
    }
}
struct StoreS2m { bf16* H; int b, k1, g, mb; float sc;
    DI void operator()(int m, int ch, const f32x4& v) const { const int tp = 64 * m + k1; bf16* row = H + (size_t)(b * SEQ + tp) * DM + g * 512;
        if (mb == 4) { if (ch == 0) *(GAS unsigned short*)(row + 256) = (unsigned short)pk2(v[0] * sc, 0.f); return; }
        v2u p; p.x = pk2(v[0] * sc, v[1] * sc); p.y = pk2(v[2] * sc, v[3] * sc);
        *(GAS v2u*)(row + mb * 64 + ch) = p;
        bf16* mrow = H + (size_t)(b * SEQ + ((SEQ - tp) & (SEQ - 1))) * DM + g * 512 + 256 + mb * 64 + ch;
        if (mb == 0 && ch == 0) { *(GAS unsigned short*)(mrow + 1) = (unsigned short)(p.x >> 16); *(GAS unsigned*)(mrow + 2) = p.y; }
        else *(GAS v2u*)(mrow) = p; } };
struct SpecS2 { const bf16* T; bf16* Hb;
    DI RowInS2 rin(int u) const { const int b = u / 1280, r = u % 1280, k1 = r / 20, g = (r % 20) / 5, mb = r % 5; return RowInS2{T + (size_t)(b * SEQ + k1 * 64) * 4096 + g * 1024 + mb * 64}; }
    DI StoreS2m sto(int u) const { const int b = u / 1280, r = u % 1280, k1 = r / 20, g = (r % 20) / 5, mb = r % 5; return StoreS2m{Hb, b, k1, g, mb, 0.000690533966f  }; } };

DI void s1_pipe8(const Frame& F, const bf16* UC, bf16* T, int u0, const bf16* Mx  ) {
    constexpr int TILE = 128 * 144;
    const int l15 = F.lane & 15, l4 = F.lane >> 4, q = l15 >> 2, pp = l15 & 3;
    const int kt = F.wave & 3, cp = F.wave >> 2;
    bf16x8 mcs[2], msn[2];
#pragma unroll
    for (int kk = 0; kk < 2; ++kk) { mcs[kk] = ld_frag_g(Mx + (size_t)(kt * 16 + l15) * 64 + kk * 32 + 8 * l4); msn[kk] = ld_frag_g(Mx + (size_t)(64 + kt * 16 + l15) * 64 + kk * 32 + 8 * l4); }
#define S1_ROW(u, row) (UC + ((size_t)(((u) >> 10) * SEQ + (((u) >> 4) & 63)) + (size_t)64 * ((row) & 63)) * 2048 + (((u) >> 2) & 3) * 512 + ((row) >> 6) * 256 + ((u) & 3) * 64)
    v4u pre[2];
#pragma unroll
    for (int i = 0; i < 2; ++i) { const int p = F.tid + 512 * i; pre[i] = *(const GAS v4u*)(S1_ROW(u0, p >> 3) + (p & 7) * 8); }
#pragma unroll
    for (int i = 0; i < 2; ++i) { const int p = F.tid + 512 * i; *(LAS v4u*)(F.lds + (p >> 3) * 144 + (p & 7) * 16) = pre[i]; }
    __syncthreads();
    for (int k = 0; k < 8; ++k) {
        LAS unsigned char* D = F.lds + (k & 1) * TILE;
        const int u = u0 + k;
        if (k + 1 < 8) {
#pragma unroll
            for (int i = 0; i < 2; ++i) { const int p = F.tid + 512 * i; pre[i] = *(const GAS v4u*)(S1_ROW(u + 1, p >> 3) + (p & 7) * 8); } }
        const int b = u >> 10, n2 = (u >> 4) & 63, g = (u >> 2) & 3, mb = u & 3;
        bf16* Tb = T + ((size_t)(b * SEQ + n2) + (size_t)(kt * 16 + l15) * 64) * 4096 + g * 1024 + mb * 64;
#pragma unroll
        for (int i = 0; i < 2; ++i) { const int ct = 2 * cp + i; f32x4 cA = {0.f, 0.f, 0.f, 0.f}, sA = cA, cB = cA, sB = cA;
#pragma unroll
            for (int kk = 0; kk < 2; ++kk) {
                const LAS unsigned char* ad = D + (kk * 32 + 8 * l4 + q) * 144 + (ct * 16 + 4 * pp) * 2;
                const s16x4 lo = vtr(ad), hi = vtr(ad + 4 * 144); const bf16x8 af = __builtin_shufflevector(lo, hi, 0, 1, 2, 3, 4, 5, 6, 7);
                cA = mfma16(af, mcs[kk], cA); sA = mfma16(af, msn[kk], sA);
                const LAS unsigned char* bd = ad + 64 * 144;
                const s16x4 lo2 = vtr(bd), hi2 = vtr(bd + 4 * 144); const bf16x8 bf_ = __builtin_shufflevector(lo2, hi2, 0, 1, 2, 3, 4, 5, 6, 7);
                cB = mfma16(bf_, mcs[kk], cB); sB = mfma16(bf_, msn[kk], sB); }
            f32x4 sre = cA + sB, sim = cB - sA;
            if (mb == 0 && ct == 0 && l4 == 0) { sre[0] = cA[0]; sim[0] = -sA[0];
                *(GAS unsigned short*)(Tb + 256) = (unsigned short)pk2(cB[0], 0.f); *(GAS unsigned short*)(Tb + 512 + 256) = (unsigned short)pk2(-sB[0], 0.f); }
            const int ch = ct * 16 + 4 * l4; v2u p;
            p.x = pk2(sre[0], sre[1]); p.y = pk2(sre[2], sre[3]); *(GAS v2u*)(Tb + ch) = p;
            p.x = pk2(sim[0], sim[1]); p.y = pk2(sim[2], sim[3]); *(GAS v2u*)(Tb + 512 + ch) = p; }
        if (k + 1 < 8) { LAS unsigned char* Dn = F.lds + ((k + 1) & 1) * TILE;
#pragma unroll
            for (int i = 0; i < 2; ++i) { const int p = F.tid + 512 * i; *(LAS v4u*)(Dn + (p >> 3) * 144 + (p & 7) * 16) = pre[i]; } }
        __syncthreads();
    }
#undef S1_ROW
}
DI void ctx_unit(const Frame& F, const bf16* UC, bf16* Hb, int unit, const bf16* MC  ) {
    const int kq = unit & 3, u5 = unit >> 2, b = u5 >> 4, g = (u5 >> 2) & 3, mb = u5 & 3;
    LAS unsigned char* D = F.lds;
    const bf16* src = UC + (size_t)(NLAT + b * CTXL) * 2048 + g * 512 + mb * 64;
    for (int p = F.tid; p < 512 * 8; p += 512) { const int row = p >> 3, c8 = p & 7; *(LAS v4u*)(D + row * 144 + c8 * 16) = *(const GAS v4u*)(src + (size_t)(row & 255) * 2048 + (row >> 8) * 256 + c8 * 8); }
    __syncthreads();
    const int l15 = F.lane & 15, l4 = F.lane >> 4, q = l15 >> 2, pp = l15 & 3;
    const bf16* Mq = MC + (size_t)kq * 64 * 512; const float sc = 0.00276213586f  ;
#pragma unroll
    for (int i = 0; i < 2; ++i) { const int t = F.wave * 2 + i, mt = t >> 2, ct = t & 3; f32x4 aA = {0.f, 0.f, 0.f, 0.f}, aB = aA, aBc = aA;
        const bool z0 = (mb == 0 && ct == 0);
#pragma unroll 4
        for (int kk = 0; kk < 8; ++kk) {
            const LAS unsigned char* ad = D + (kk * 32 + 8 * l4 + q) * 144 + (ct * 16 + 4 * pp) * 2;
            const s16x4 lo = vtr(ad), hi = vtr(ad + 4 * 144); const bf16x8 af = __builtin_shufflevector(lo, hi, 0, 1, 2, 3, 4, 5, 6, 7);
            const bf16x8 mcf = ld_frag_g(Mq + (size_t)(mt * 16 + l15) * 512 + kk * 32 + 8 * l4);
            aA = mfma16(af, mcf, aA);
            const LAS unsigned char* bd = ad + 256 * 144;
            const s16x4 lo2 = vtr(bd), hi2 = vtr(bd + 4 * 144); const bf16x8 bf_ = __builtin_shufflevector(lo2, hi2, 0, 1, 2, 3, 4, 5, 6, 7);
            aB = mfma16(bf_, ld_frag_g(Mq + (size_t)(mt * 16 + l15) * 512 + 256 + kk * 32 + 8 * l4), aB);
            if (z0) aBc = mfma16(bf_, mcf, aBc); }
        f32x4 sm = aA + aB; const int kp = kq * 64 + mt * 16 + l15, pos = mb * 64 + ct * 16 + 4 * l4;
        const bool sp0 = z0 && l4 == 0;
        if (sp0) sm[0] = aA[0];
        bf16* o = Hb + (size_t)(NLAT + b * CTXL + kp) * DM + g * 512; v2u p;
        p.x = pk2(sm[0] * sc, sm[1] * sc); p.y = pk2(sm[2] * sc, sm[3] * sc); *(GAS v2u*)(o + pos) = p;
        bf16* mo = Hb + (size_t)(NLAT + b * CTXL + ((CTXL - kp) & (CTXL - 1))) * DM + g * 512 + 256 + pos;
        if (sp0) { *(GAS unsigned short*)(mo + 1) = (unsigned short)(p.x >> 16); *(GAS unsigned*)(mo + 2) = p.y; *(GAS unsigned short*)(o + 256) = (unsigned short)pk2(aBc[0] * sc, 0.f); }
        else *(GAS v2u*)(mo) = p; }
    __syncthreads();
}
DI void phase_fnet_s1(const Frame& F0, const Args& a, int with_ctx) {
    const Frame F = launder(F0);
    unsigned char* ws = launder_ptr(a.ws); const bf16* UC = (const bf16*)(ws + WS_UC); bf16* T = (bf16*)(ws + WS_T); bf16* Hb = (bf16*)(ws + WS_H);
    if (with_ctx) for (int unit = (int)blockIdx.x; unit < 128; unit += F.G) ctx_unit(F, UC, Hb, unit, (const bf16*)(ws + WS_MC));
    for (int cb = F.vcu; cb < 256; cb += F.G) { const int n2 = (cb >> 1) & 63; s1_pipe8(F, UC, T, cb * 8, (const bf16*)(ws + WS_M1) + (size_t)n2 * 128 * 64); }
}
DI void phase_fnet_s2(const Frame& F0, const Args& a) {
    const Frame F = launder(F0);
    unsigned char* ws = launder_ptr(a.ws); const SpecS2 sp{(const bf16*)(ws + WS_T), (bf16*)(ws + WS_H)};
    for (int cb = F.vcu; cb < 256; cb += F.G) dft_pipe16<64, SpecS2, 10>(F, sp, cb * 10, (const bf16*)(ws + WS_M2));
}

#define SITE(n) (((SITE_MASK) >> (n)) & 1u)
constexpr int N_PHASES = 2 + 10 * DEPTH - 1;
template <unsigned SITE_MASK> __global__ void __launch_bounds__(NWAVES * 64, 2) fwd_kernel(Args args) {
    extern __shared__ __attribute__((aligned(16))) unsigned char lds_raw[];
    Frame F; F.lds = (LAS unsigned char*)lds_raw;
    F.tid = threadIdx.x; F.lane = F.tid & 63; F.wave = __builtin_amdgcn_readfirstlane(F.tid >> 6);
    F.G = gridDim.x; { const int bx = blockIdx.x; F.vcu = (F.G % 8 == 0) ? (bx % 8) * (F.G / 8) + bx / 8 : bx; }
    unsigned char* ws = args.ws;
    volatile LAS unsigned* MISC = (volatile LAS unsigned*)(F.lds + MISC_OFF);
    for (int u = F.tid; u < (LDS_BYTES - MISC_OFF) / 4; u += NWAVES * 64) ((LAS unsigned*)(F.lds + MISC_OFF))[u] = 0u;
    __syncthreads();
    const int lo = args.ph_lo, hi = args.ph_hi;
    XcdBarrier bar; bar.bar = (unsigned*)(ws + WS_CTL) + CW_BAR; bar.x = 0; bar.st = nullptr;
    if (hi - lo > 1) bar = xcd_barrier_post((unsigned*)(ws + WS_CTL) + CW_BAR, MISC + 8);
#define IN(k) (lo <= (k) && (k) < hi)
#define SEAM(k) do { if (IN(k) && IN((k) + 1)) xcd_barrier(bar); } while (0)
#define WSP launder_ptr(args.ws)
#define mod ((const float*)(WSP + WS_MOD))
#define XA ((bf16*)(WSP + WS_XA))
#define Hb ((bf16*)(WSP + WS_H))
#define Yb ((bf16*)(WSP + WS_Y))
#define ACT ((bf16*)(WSP + WS_ACT))

    if (SITE(0) && IN(0)) for (int rep_ = 0, nrep_ = 1 + ((args.rep_mask >> 0) & 1); rep_ < nrep_; ++rep_) { phase_prologue(F, args); } SEAM(0);
    if (SITE(1) && IN(1)) for (int rep_ = 0, nrep_ = 1 + ((args.rep_mask >> 1) & 1); rep_ < nrep_; ++rep_) { phase_norm(F, MROWS, args.x, args.ctx, 0, nullptr, nullptr, nullptr, nullptr, nullptr, 0, Hb, args.norm_gains + 0 * DM, mod + 0 * DM, mod + 1 * DM); } SEAM(1);

    for (int li = 0; li < DEPTH; ++li) {
        const int pb = 2 + 10 * li; const int jl = li >> 1; const bool is_gla = (li & 1) == 0; const bool need_ctx = li < DEPTH - 1;
        const int nrows = li < 2 ? MROWS : NLAT;
        const int pms_in = li < 3 ? 272 : 256, pms_out = li < 2 ? 272 : 256;
        const float* modl = mod + (size_t)li * 3 * NADA; const float* gains = args.norm_gains + (size_t)li * 4 * DM;
        const void* xin_lat = li == 0 ? (const void*)args.x : (const void*)XA; const void* xin_ctx = li == 0 ? (const void*)args.ctx : (const void*)(XA + (size_t)NLAT * DM);
        if (is_gla) {
            const int colmajor = jl & 1;
            if (SITE(2) && IN(pb + 0)) for (int rep_ = 0, nrep_ = 1 + ((args.rep_mask >> 2) & 1); rep_ < nrep_; ++rep_) { pg8::Gemm g{Hb, (const bf16*)(WSP + WS_WIN) + (size_t)jl * GIN_PAD * DM, DM, DM, DM, 24, pms_in}; pg8::StaticOrder S; S.init(32, 24, F.G, (int)blockIdx.x);
                pg8::EpiWin E{(bf16*)(WSP + WS_Q), (bf16*)(WSP + WS_K), (bf16*)(WSP + WS_V), (bf16*)(WSP + WS_R), pms_in};
                pg8::gemm_phase<pg8::EpiWin, pg8::StaticOrder>(F.lds, g, S, E); phase_lr(F, args, jl); } SEAM(pb + 0);
            if (SITE(3) && IN(pb + 1)) for (int rep_ = 0, nrep_ = 1 + ((args.rep_mask >> 3) & 1); rep_ < nrep_; ++rep_) { phase_chunk_prep(F, args, jl, colmajor); } SEAM(pb + 1);
            if (SITE(4) && IN(pb + 2)) for (int rep_ = 0, nrep_ = 1 + ((args.rep_mask >> 4) & 1); rep_ < nrep_; ++rep_) { phase_scan(F, args, colmajor); } SEAM(pb + 2);
            if (SITE(5) && IN(pb + 3)) for (int rep_ = 0, nrep_ = 1 + ((args.rep_mask >> 5) & 1); rep_ < nrep_; ++rep_) { phase_gla_post(F, args, jl, nrows); } SEAM(pb + 3);
            if (SITE(6) && IN(pb + 4)) for (int rep_ = 0, nrep_ = 1 + ((args.rep_mask >> 6) & 1); rep_ < nrep_; ++rep_) { pg8::Gemm g{Hb, (const bf16*)(WSP + WS_WGO) + (size_t)jl * DM * DM, DM, DM, DM, 8, pms_out}; pg8::StaticOrder S; S.init(32, 8, F.G, (int)blockIdx.x);
                pg8::EpiBf16 E{Yb, DM, pms_out}; pg8::gemm_phase<pg8::EpiBf16, pg8::StaticOrder>(F.lds, g, S, E); } SEAM(pb + 4);
        } else {
            if (SITE(7) && IN(pb + 0)) for (int rep_ = 0, nrep_ = 1 + ((args.rep_mask >> 7) & 1); rep_ < nrep_; ++rep_) { pg8::Gemm g{Hb, (const bf16*)(WSP + WS_DFTC), 512, DM, 512, 2, pms_in}; pg8::StaticOrder S; S.init(32, 8, F.G, (int)blockIdx.x);
                pg8::EpiBf16 E{(bf16*)(WSP + WS_UC), 2048, pms_in}; pg8::gemm_phase<pg8::EpiBf16, pg8::StaticOrder>(F.lds, g, S, E); } SEAM(pb + 0);
            if (SITE(8) && IN(pb + 1)) for (int rep_ = 0, nrep_ = 1 + ((args.rep_mask >> 8) & 1); rep_ < nrep_; ++rep_) { phase_fnet_s1(F, args, need_ctx ? 1 : 0); } SEAM(pb + 1);
            if (SITE(9) && IN(pb + 2)) for (int rep_ = 0, nrep_ = 1 + ((args.rep_mask >> 9) & 1); rep_ < nrep_; ++rep_) { phase_fnet_s2(F, args); } SEAM(pb + 2);
            if (SITE(10) && IN(pb + 4)) for (int rep_ = 0, nrep_ = 1 + ((args.rep_mask >> 10) & 1); rep_ < nrep_; ++rep_) { pg8::Gemm g{Hb, (const bf16*)(WSP + WS_WFO) + (size_t)jl * DM * DM, DM, DM, DM, 8, pms_out}; pg8::StaticOrder S; S.init(32, 8, F.G, (int)blockIdx.x);
                pg8::EpiBf16 E{Yb, DM, pms_out}; pg8::gemm_phase<pg8::EpiBf16, pg8::StaticOrder>(F.lds, g, S, E); } SEAM(pb + 4);
        }
        if (SITE(11) && IN(pb + 5)) for (int rep_ = 0, nrep_ = 1 + ((args.rep_mask >> 11) & 1); rep_ < nrep_; ++rep_) { phase_norm(F, nrows, xin_lat, xin_ctx, li != 0, Yb, gains + 1 * DM, modl + 2 * DM, XA, XA + (size_t)NLAT * DM, 1, Hb, gains + 2 * DM, modl + 3 * DM, modl + 4 * DM); } SEAM(pb + 5);
        if (SITE(12) && IN(pb + 6)) for (int rep_ = 0, nrep_ = 1 + ((args.rep_mask >> 12) & 1); rep_ < nrep_; ++rep_) { pg8::Gemm g{Hb, (const bf16*)(WSP + WS_WGU) + (size_t)li * 2 * DFF * DM, DM, DM, DM, 44, 256}; pg8::StaticOrder S; S.init(li < 2 ? 34 : 32, li < 2 ? 44 : 40, F.G, (int)blockIdx.x);
            pg8::EpiSwiglu E{ACT, DFF, 256}; pg8::gemm_phase<pg8::EpiSwiglu, pg8::StaticOrder>(F.lds, g, S, E);
            if (li >= 2) { pg8::Gemm gh{Hb, (const bf16*)(WSP + WS_WGU) + ((size_t)li * 2 * DFF + 40 * 256) * DM, DM, DM, DM, 4, 256}; pg8::StaticOrder Sh; Sh.init(64, 4, F.G, (int)blockIdx.x);
                pg8::EpiSwigluH Eh{ACT + 40 * 128, DFF}; pg8::gemm_phase<pg8::EpiSwigluH, pg8::StaticOrder, true>(F.lds, gh, Sh, Eh); } } SEAM(pb + 6);
        if (SITE(13) && IN(pb + 7)) for (int rep_ = 0, nrep_ = 1 + ((args.rep_mask >> 13) & 1); rep_ < nrep_; ++rep_) { pg8::Gemm g{ACT, (const bf16*)(WSP + WS_WDN) + (size_t)li * DM * DFF, DFF, DFF, DFF, 8, pms_out}; pg8::StaticOrder S; S.init(32, 8, F.G, (int)blockIdx.x);
            pg8::EpiBf16 E{Yb, DM, pms_out}; pg8::gemm_phase<pg8::EpiBf16, pg8::StaticOrder>(F.lds, g, S, E); } SEAM(pb + 7);
        if (SITE(14) && IN(pb + 8)) for (int rep_ = 0, nrep_ = 1 + ((args.rep_mask >> 14) & 1); rep_ < nrep_; ++rep_) {
            if (li < DEPTH - 1) { const float* modn = mod + (size_t)(li + 1) * 3 * NADA; const float* gn = args.norm_gains + (size_t)(li + 1) * 4 * DM;
                phase_norm(F, nrows, XA, XA + (size_t)NLAT * DM, 1, Yb, gains + 3 * DM, modl + 5 * DM, XA, XA + (size_t)NLAT * DM, 1, Hb, gn, modn + 0 * DM, modn + 1 * DM); }
            else phase_norm(F, NLAT, XA, XA + (size_t)NLAT * DM, 1, Yb, gains + 3 * DM, modl + 5 * DM, args.out, args.out, 0, nullptr, nullptr, nullptr, nullptr);
        } SEAM(pb + 8);
    }
#undef IN
#undef SEAM
#undef WSP
#undef mod
#undef XA
#undef Hb
#undef Yb
#undef ACT
}

#if MK_N_LAUNCHES != 1
static int site_of_phase(int p) {
    if (p == 0) return 0; if (p == 1) return 1;
    const int rel = (p - 2) % 10, li = (p - 2) / 10; const bool gla = (li & 1) == 0;
    switch (rel) { case 0: return gla ? 2 : 7; case 1: return gla ? 3 : 8; case 2: return gla ? 4 : 9; case 3: return gla ? 5 : -1; case 4: return gla ? 6 : 10;
                   case 5: return 11; case 6: return 12; case 7: return 13; case 8: return 14; default: return -1; }
}
typedef void (*kern_t)(Args);
template <unsigned M> static kern_t kern_of() { return fwd_kernel<M>; }
static kern_t site_kernel(int site) {
    switch (site) { case 0: return kern_of<1u << 0>(); case 1: return kern_of<1u << 1>(); case 2: return kern_of<1u << 2>(); case 3: return kern_of<1u << 3>(); case 4: return kern_of<1u << 4>();
                    case 5: return kern_of<1u << 5>(); case 6: return kern_of<1u << 6>(); case 7: return kern_of<1u << 7>(); case 8: return kern_of<1u << 8>(); case 9: return kern_of<1u << 9>();
                    case 10: return kern_of<1u << 10>(); case 11: return kern_of<1u << 11>(); case 12: return kern_of<1u << 12>(); case 13: return kern_of<1u << 13>(); default: return kern_of<1u << 14>(); }
}
#endif
extern "C" void kernel_launch(void* const* d_in, const int* in_sizes, int n_in, void* d_out, int out_size, void* d_ws, size_t ws_size, hipStream_t stream) {
    static int grid = 0;
    if (grid == 0) {
        if (n_in != 17 || in_sizes[0] != NLAT * DM || out_size != NLAT * DM || ws_size < WS_END) {
            fprintf(stderr, "kernel_launch: unexpected shapes: n_in %d in0 %d out %d ws %zu (need %zu); nothing launched\n", n_in, n_in > 0 ? in_sizes[0] : -1, out_size, ws_size, (size_t)WS_END); grid = -1; return; }
        int dev = 0, cus = 0;
        if (hipGetDevice(&dev) != hipSuccess || hipDeviceGetAttribute(&cus, hipDeviceAttributeMultiprocessorCount, dev) != hipSuccess) { grid = -1; return; }
#if MK_N_LAUNCHES == 1
        if (hipFuncSetAttribute((const void*)fwd_kernel<FULL_MASK>, hipFuncAttributeMaxDynamicSharedMemorySize, LDS_BYTES) != hipSuccess) { fprintf(stderr, "kernel_launch: hipFuncSetAttribute failed\n"); grid = -1; return; }
#else
        for (int sidx = 0; sidx < 15; ++sidx) if (hipFuncSetAttribute((const void*)site_kernel(sidx), hipFuncAttributeMaxDynamicSharedMemorySize, LDS_BYTES) != hipSuccess) { fprintf(stderr, "kernel_launch: hipFuncSetAttribute failed\n"); grid = -1; return; }
#endif
        int occ = 0;
#if MK_N_LAUNCHES == 1
        if (hipOccupancyMaxActiveBlocksPerMultiprocessor(&occ, (const void*)fwd_kernel<FULL_MASK>, NWAVES * 64, LDS_BYTES) != hipSuccess || occ < 1) { fprintf(stderr, "kernel_launch: the occupancy query reports %d resident workgroups per CU; nothing launched\n", occ); grid = -1; return; }
#endif
        (void)hipGetLastError();
        grid = cus;
    }
    if (grid < 0) return;
    (void)hipMemsetAsync((char*)d_ws + WS_CTL, 0, CTL_ZERO_BYTES, stream);
    Args a{};
    a.x = (const float*)d_in[0]; a.c = (const float*)d_in[1]; a.ctx = (const float*)d_in[2]; a.c_ctx = (const float*)d_in[3]; a.ada_w = (const float*)d_in[4]; a.ada_b = (const float*)d_in[5];
    a.norm_gains = (const float*)d_in[6]; a.gla_w_in = (const float*)d_in[7]; a.gla_wg2_f = (const float*)d_in[8]; a.gla_bg_f = (const float*)d_in[9]; a.gla_wg2_b = (const float*)d_in[10]; a.gla_bg_b = (const float*)d_in[11];
    a.gla_head_gain = (const float*)d_in[12]; a.gla_w_out = (const float*)d_in[13]; a.fnet_w_out = (const float*)d_in[14]; a.ffn_w_gu = (const float*)d_in[15]; a.ffn_w_down = (const float*)d_in[16];
    a.out = (float*)d_out; a.ws = (unsigned char*)d_ws; a.rep_mask = PROBE_REP_MASK;
#if MK_N_LAUNCHES == 1
    a.ph_lo = 0; a.ph_hi = N_PHASES;
    hipLaunchKernelGGL(fwd_kernel<FULL_MASK>, dim3(grid), dim3(NWAVES * 64), LDS_BYTES, stream, a);
#else
    for (int p = 0; p < N_PHASES; ++p) {
        const int site = site_of_phase(p); if (site < 0) continue;
        a.ph_lo = p; a.ph_hi = p + 1;
        hipLaunchKernelGGL(site_kernel(site), dim3(grid), dim3(NWAVES * 64), LDS_BYTES, stream, a);
    }
#endif
}
```
